# Optimizing an MI355X kernel written in HIP

```python
import jax, jax.numpy as jnp
from jax import lax
import numpy as np


D_MODEL = 1024
BATCH = 8
SEQ = 4096
DEPTH = 4

GRID_W = 64
CTX_LEN = 256
N_MIXERS = 2
N_ATT_LAYERS = (DEPTH + 1) // 2
N_RET_LAYERS = DEPTH // 2

ATT_HEADS = 8
ATT_KV_HEADS = 2
ATT_HEAD_DIM = D_MODEL // ATT_HEADS
ATT_GROUP = ATT_HEADS // ATT_KV_HEADS
ATT_WIDTH = ATT_HEADS * ATT_HEAD_DIM
ATT_KV_WIDTH = ATT_KV_HEADS * ATT_HEAD_DIM
ATT_IN = 2 * ATT_WIDTH + 2 * ATT_KV_WIDTH
Q_BLOCK = 128
ROPE_THETA = 10000.0

RET_HEADS = 4
RET_QK_DIM = D_MODEL // RET_HEADS
RET_V_DIM = 2 * RET_QK_DIM
RET_QK_WIDTH = RET_HEADS * RET_QK_DIM
RET_V_WIDTH = RET_HEADS * RET_V_DIM
RET_IN = 2 * RET_QK_WIDTH + 2 * RET_V_WIDTH
RET_CHUNK = 128

DEEPNORM_ALPHA = (2.0 * DEPTH) ** 0.25
DEEPNORM_BETA = (8.0 * DEPTH) ** -0.25
LN_EPS = 1e-5
QK_EPS = 1e-6
GN_EPS = 1e-5

kernel_name = 'hybrid_gqa_retention_prefix_flow_block'


def layer_norm(x, g, b):
    xf = x.astype(jnp.float32)
    mu = xf.mean(-1, keepdims=True)
    var = jnp.square(xf - mu).mean(-1, keepdims=True)
    return ((xf - mu) * lax.rsqrt(var + LN_EPS) * g.astype(jnp.float32) + b.astype(jnp.float32)).astype(x.dtype)


def rms_norm(x, g):
    xf = x.astype(jnp.float32)
    ms = jnp.square(xf).mean(-1, keepdims=True)
    return (xf * lax.rsqrt(ms + QK_EPS) * g.astype(jnp.float32)).astype(x.dtype)


def rope_1d(x, pos):
    half = x.shape[-1] // 2
    freqs = ROPE_THETA ** (-jnp.arange(half, dtype=jnp.float32) / half)
    ang = pos.astype(jnp.float32)[:, None] * freqs[None, :]
    cos = jnp.cos(ang)[:, None, :]
    sin = jnp.sin(ang)[:, None, :]
    xf = x.astype(jnp.float32)
    x1, x2 = xf[..., :half], xf[..., half:]
    return jnp.concatenate([x1 * cos - x2 * sin, x1 * sin + x2 * cos], axis=-1).astype(x.dtype)


def axial_rope(x, row, col):
    half = x.shape[-1] // 2
    return jnp.concatenate([rope_1d(x[..., :half], row), rope_1d(x[..., half:], col)], axis=-1)


def attend(q, k, v):
    s = jnp.einsum('bqkgd,bskd->bkgqs', q, k).astype(jnp.float32) * (ATT_HEAD_DIM ** -0.5)
    p = jax.nn.softmax(s, axis=-1).astype(v.dtype)
    return jnp.einsum('bkgqs,bskd->bqkgd', p, v)


def attention_mixer(h_lat, h_ctx, w_in, w_out, q_scale, k_scale, row, col, need_ctx):
    B, S, _ = h_lat.shape
    L = h_ctx.shape[1]

    def project(h):
        n = h.shape[1]
        p = h @ w_in
        q, g, k, v = jnp.split(p, [ATT_WIDTH, 2 * ATT_WIDTH, 2 * ATT_WIDTH + ATT_KV_WIDTH], axis=-1)
        q = rms_norm(q.reshape(B, n, ATT_HEADS, ATT_HEAD_DIM), q_scale)
        k = rms_norm(k.reshape(B, n, ATT_KV_HEADS, ATT_HEAD_DIM), k_scale)
        v = v.reshape(B, n, ATT_KV_HEADS, ATT_HEAD_DIM)
        return q, k, v, g

    q_l, k_l, v_l, g_l = project(h_lat)
    q_l = axial_rope(q_l, row, col)
    k_l = axial_rope(k_l, row, col)
    q_c, k_c, v_c, g_c = project(h_ctx)
    k_all = jnp.concatenate([k_l, k_c], axis=1)
    v_all = jnp.concatenate([v_l, v_c], axis=1)

    nb = S // Q_BLOCK
    qb = q_l.reshape(B, nb, Q_BLOCK, ATT_KV_HEADS, ATT_GROUP, ATT_HEAD_DIM).transpose(1, 0, 2, 3, 4, 5)
    o_l = lax.map(lambda qblk: attend(qblk, k_all, v_all), qb)
    o_l = o_l.transpose(1, 0, 2, 3, 4, 5).reshape(B, S, ATT_WIDTH)
    y_l = (o_l * jax.nn.silu(g_l)) @ w_out
    y_c = None
    if need_ctx:
        o_c = attend(q_c.reshape(B, L, ATT_KV_HEADS, ATT_GROUP, ATT_HEAD_DIM), k_c, v_c).reshape(B, L, ATT_WIDTH)
        y_c = (o_c * jax.nn.silu(g_c)) @ w_out
    return y_l, y_c


def decayed_state(k, v, log_g):
    n = k.shape[2]
    w = jnp.exp(log_g.astype(jnp.float32)[:, None] * (n - 1 - jnp.arange(n, dtype=jnp.float32))[None, :])
    return jnp.einsum('bhld,hl,bhle->bhde', k, w.astype(k.dtype), v)


def retention_chunkwise(q, k, v, log_g, state0, strict):
    B, H, N, _ = q.shape
    dv = v.shape[-1]
    C = RET_CHUNK
    nc = N // C
    idx = jnp.arange(C, dtype=jnp.float32)
    lg = log_g.astype(jnp.float32)[:, None]
    diff = idx[:, None] - idx[None, :]
    mask = (diff > 0) if strict else (diff >= 0)
    decay = jnp.where(mask, jnp.exp(lg[:, :, None] * jnp.maximum(diff, 0.0)), 0.0).astype(q.dtype)
    xi = jnp.exp(lg * (idx + 1.0)).astype(q.dtype)
    zeta = jnp.exp(lg * (C - 1.0 - idx)).astype(q.dtype)
    g_chunk = jnp.exp(lg[:, 0] * C).astype(q.dtype)

    def chunks(t):
        return t.reshape(B, H, nc, C, t.shape[-1]).transpose(2, 0, 1, 3, 4)

    def step(state, qkv):
        qc, kc, vc = qkv
        s = jnp.einsum('bhnd,bhmd->bhnm', qc, kc) * decay
        o = jnp.einsum('bhnm,bhme->bhne', s, vc) + jnp.einsum('bhnd,bhde->bhne', qc, state) * xi[..., None]
        state = state * g_chunk[:, None, None] + jnp.einsum('bhmd,bhme->bhde', kc * zeta[..., None], vc)
        return state, o

    _, o = lax.scan(step, state0.astype(q.dtype), (chunks(q), chunks(k), chunks(v)))
    return o.transpose(1, 2, 0, 3, 4).reshape(B, H, N, dv)


def retention_mixer(h_lat, h_ctx, w_in, w_out, gn_g, lg_f, lg_b, need_ctx):
    B, S, _ = h_lat.shape
    L = h_ctx.shape[1]

    def project(h, pos):
        n = h.shape[1]
        p = h @ w_in
        q, k, v, g = jnp.split(p, [RET_QK_WIDTH, 2 * RET_QK_WIDTH, 2 * RET_QK_WIDTH + RET_V_WIDTH], axis=-1)
        q = rope_1d(q.reshape(B, n, RET_HEADS, RET_QK_DIM), pos).transpose(0, 2, 1, 3)
        k = (rope_1d(k.reshape(B, n, RET_HEADS, RET_QK_DIM), pos) * (RET_QK_DIM ** -0.5)).transpose(0, 2, 1, 3)
        v = v.reshape(B, n, RET_HEADS, RET_V_DIM).transpose(0, 2, 1, 3)
        return q, k, v, g

    def flip(t):
        return jnp.flip(t, axis=2)

    def output(o, g):
        of = o.astype(jnp.float32)
        mu = of.mean(-1, keepdims=True)
        var = jnp.square(of - mu).mean(-1, keepdims=True)
        on = ((of - mu) * lax.rsqrt(var + GN_EPS) * gn_g.astype(jnp.float32).reshape(RET_HEADS, 1, RET_V_DIM)).astype(o.dtype)
        n = o.shape[2]
        on = on.transpose(0, 2, 1, 3).reshape(B, n, RET_V_WIDTH)
        return (on * jax.nn.silu(g)) @ w_out

    q_c, k_c, v_c, g_c = project(h_ctx, jnp.arange(L))
    q_l, k_l, v_l, g_l = project(h_lat, L + jnp.arange(S))
    s_f = decayed_state(k_c, v_c, lg_f)
    s_b = decayed_state(flip(k_c), flip(v_c), lg_b)
    o_l = (retention_chunkwise(q_l, k_l, v_l, lg_f, s_f, False)
           + flip(retention_chunkwise(flip(q_l), flip(k_l), flip(v_l), lg_b, s_b, True)))
    y_l = output(o_l, g_l)
    y_c = None
    if need_ctx:
        zero = jnp.zeros_like(s_f)
        o_c = (retention_chunkwise(q_c, k_c, v_c, lg_f, zero, False)
               + flip(retention_chunkwise(flip(q_c), flip(k_c), flip(v_c), lg_b, zero, True)))
        y_c = output(o_c, g_c)
    return y_l, y_c


def setup_inputs(seed: int = 0) -> dict:
    key = jax.random.key(seed)
    ks = jax.random.split(key, 20)
    f32 = jnp.float32
    nrm = lambda k, shape: jax.random.normal(k, shape, dtype=f32)
    base_decay = jnp.log(1.0 - 2.0 ** (-5.0 - jnp.arange(RET_HEADS, dtype=f32)))
    return {
        'x': nrm(ks[0], (BATCH, SEQ, D_MODEL)),
        'c': nrm(ks[1], (BATCH, D_MODEL)),
        'ctx': nrm(ks[2], (BATCH, CTX_LEN, D_MODEL)),
        'c_ctx': nrm(ks[3], (D_MODEL,)),
        'mod_w': nrm(ks[4], (DEPTH, D_MODEL, 3 * D_MODEL)) * (0.5 * D_MODEL ** -0.5),
        'mod_b': nrm(ks[5], (DEPTH, 3 * D_MODEL)) * 0.01,
        'ln_g': 1.0 + 0.02 * nrm(ks[6], (DEPTH, D_MODEL)),
        'ln_b': 0.02 * nrm(ks[7], (DEPTH, D_MODEL)),
        'attn_w_in': nrm(ks[8], (N_ATT_LAYERS, D_MODEL, ATT_IN)) * (D_MODEL ** -0.5),
        'attn_w_out': nrm(ks[9], (N_ATT_LAYERS, ATT_WIDTH, D_MODEL)) * (ATT_WIDTH ** -0.5) * DEEPNORM_BETA,
        'attn_q_scale': 1.0 + 0.02 * nrm(ks[10], (N_ATT_LAYERS, ATT_HEAD_DIM)),
        'attn_k_scale': 1.0 + 0.02 * nrm(ks[11], (N_ATT_LAYERS, ATT_HEAD_DIM)),
        'ret_w_in': nrm(ks[12], (N_RET_LAYERS, D_MODEL, RET_IN)) * (D_MODEL ** -0.5),
        'ret_w_out': nrm(ks[13], (N_RET_LAYERS, RET_V_WIDTH, D_MODEL)) * (RET_V_WIDTH ** -0.5) * DEEPNORM_BETA,
        'ret_gn_g': 1.0 + 0.02 * nrm(ks[14], (N_RET_LAYERS, RET_V_WIDTH)),
        'ret_log_decay_fwd': base_decay[None, :] * jnp.exp(0.1 * nrm(ks[15], (N_RET_LAYERS, RET_HEADS))),
        'ret_log_decay_bwd': base_decay[None, :] * jnp.exp(0.1 * nrm(ks[16], (N_RET_LAYERS, RET_HEADS))),
    }


def reference(x, c, ctx, c_ctx, mod_w, mod_b, ln_g, ln_b, attn_w_in, attn_w_out, attn_q_scale, attn_k_scale,
              ret_w_in, ret_w_out, ret_gn_g, ret_log_decay_fwd, ret_log_decay_bwd):
    S = x.shape[1]
    ROWS = S // GRID_W
    row = jnp.repeat(jnp.arange(ROWS), GRID_W)
    col = jnp.tile(jnp.arange(GRID_W), ROWS)
    sc = jax.nn.silu(c)
    scc = jax.nn.silu(c_ctx)
    for i in range(DEPTH):
        need_ctx = i < DEPTH - 1
        shift, scale, gate = jnp.split(sc @ mod_w[i] + mod_b[i], 3, axis=-1)
        shift_c, scale_c, gate_c = jnp.split(scc @ mod_w[i] + mod_b[i], 3, axis=-1)
        h_lat = x * (1.0 + scale[:, None, :]) + shift[:, None, :]
        h_ctx = ctx * (1.0 + scale_c) + shift_c
        j = i // N_MIXERS
        if i % N_MIXERS == 0:
            y_l, y_c = attention_mixer(h_lat, h_ctx, attn_w_in[j], attn_w_out[j], attn_q_scale[j], attn_k_scale[j],
                                       row, col, need_ctx)
        else:
            y_l, y_c = retention_mixer(h_lat, h_ctx, ret_w_in[j], ret_w_out[j], ret_gn_g[j],
                                       ret_log_decay_fwd[j], ret_log_decay_bwd[j], need_ctx)
        x = layer_norm(DEEPNORM_ALPHA * x + gate[:, None, :] * y_l, ln_g[i], ln_b[i])
        if need_ctx:
            ctx = layer_norm(DEEPNORM_ALPHA * ctx + gate_c * y_c, ln_g[i], ln_b[i])
    return x
```

```cpp
#include <hip/hip_runtime.h>
#include <hip/hip_cooperative_groups.h>
#include <cstdio>
#include <cstdint>
namespace cg = cooperative_groups;

typedef unsigned short bf16_t;
typedef short bf16x8 __attribute__((ext_vector_type(8)));
typedef short s16x4 __attribute__((ext_vector_type(4)));
typedef float f32x4 __attribute__((ext_vector_type(4)));
typedef float f32x16 __attribute__((ext_vector_type(16)));
typedef float f32x8 __attribute__((ext_vector_type(8)));
typedef unsigned u32x4 __attribute__((ext_vector_type(4)));
typedef unsigned u32x2 __attribute__((ext_vector_type(2)));
typedef _Float16 h16x2 __attribute__((ext_vector_type(2)));
typedef _Float16 h16x8 __attribute__((ext_vector_type(8)));

constexpr int DM = 1024, NB = 8, SEQ = 4096, CTXL = 256;
constexpr int TL = NB * SEQ, TC = NB * CTXL, TT = TL + TC;
constexpr int KVS = SEQ + CTXL;
constexpr int ATT_IN = 2560, RET_IN = 6144;
constexpr float ALPHA = 1.681792830507429f;
constexpr int NTHREADS = 512;
constexpr int LDS_MAIN = 131072;
constexpr int LDS_BYTES = LDS_MAIN + 16;

constexpr size_t SZ_T1K = (size_t)TT * 1024 * 2;
constexpr size_t OFF_WT = 0;
constexpr size_t OFF_MOD = OFF_WT + 16777216;
constexpr size_t OFF_ROPER = OFF_MOD + 442368;
constexpr size_t OFF_ROPEA = OFF_ROPER + 2228224;
constexpr size_t OFF_CTXR = OFF_ROPEA + 16384;
constexpr size_t OFF_H = OFF_CTXR + 8388608;
constexpr size_t OFF_R1 = OFF_H + SZ_T1K;
constexpr size_t OFF_R2 = OFF_R1 + SZ_T1K;
constexpr size_t OFF_R3 = OFF_R2 + SZ_T1K;
constexpr size_t OFF_R4 = OFF_R3 + 2 * SZ_T1K;
constexpr size_t OFF_BAR = OFF_R4 + 2 * SZ_T1K;
constexpr size_t BAR_BYTES = 16384;
constexpr size_t OFF_STATS = OFF_BAR + BAR_BYTES;
constexpr size_t STATS_BYTES = (size_t)TT * 4 * 2 * 4;
constexpr size_t OFF_TCB = OFF_STATS + STATS_BYTES;
constexpr size_t WS_END = OFF_TCB + (size_t)TC * 2048 * 2;
static_assert(WS_END <= 536870912, "workspace must fit 4x the largest tensor");

struct Args {
    const float* in[17];
    float* out;
    unsigned char* ws;
};

#define DI __device__ __forceinline__
DI int opq_tid() { int t = threadIdx.x; asm volatile("" : "+v"(t)); return t; }
DI unsigned cvt_pk_bf16(float lo, float hi) { unsigned r; asm volatile("v_cvt_pk_bf16_f32 %0, %1, %2" : "=v"(r) : "v"(lo), "v"(hi)); return r; }
DI float bf2f(bf16_t b) { return __uint_as_float(((unsigned)b) << 16); }
DI float bflo(unsigned w) { return __uint_as_float(w << 16); }
DI float bfhi(unsigned w) { return __uint_as_float(w & 0xffff0000u); }
DI bf16_t f2bf(float f) { return (bf16_t)(cvt_pk_bf16(f, f) & 0xffffu); }
DI float silu_f(float x) { return x * __builtin_amdgcn_rcpf(1.f + __expf(-x)); }
DI float wave_sum(float v) {
#pragma unroll
    for (int o = 32; o >= 1; o >>= 1) v += __shfl_xor(v, o, 64);
    return v;
}


#define XB_TMO      128
#define XB_XCNT(j)  (256  + 64 * (j))
#define XB_XSUB(j)  (1280 + 64 * (j))
#define XB_XGEN(j)  (2304 + 64 * (j))
#define XB_TOP      3328
#define XB_TOPGEN   3392
#define XCD_BAR_WORDS 3456
#define XB_SPIN_CAP (1u << 18)
#define LAS __attribute__((address_space(3)))
DI unsigned xb_ld(unsigned* p)              { return __hip_atomic_load(p, __ATOMIC_RELAXED, __HIP_MEMORY_SCOPE_AGENT); }
DI unsigned xb_add(unsigned* p, unsigned v) { return __hip_atomic_fetch_add(p, v, __ATOMIC_RELAXED, __HIP_MEMORY_SCOPE_AGENT); }
DI unsigned xb_xcc_id() { return (unsigned)__builtin_amdgcn_s_getreg((3 << 11) | 20) & 0xFu; }
#define XB_SPIN(cond, bar) do { unsigned _sp = 0; while (cond) { __builtin_amdgcn_s_sleep(1); \
    if ((++_sp & 255u) == 0u) { if (xb_ld(&(bar)[XB_TMO])) break; if (_sp > XB_SPIN_CAP) { atomicAdd(&(bar)[XB_TMO], 1u); break; } } } } while (0)
struct XcdBarrier { unsigned* bar; unsigned x; volatile LAS unsigned* st; };
DI XcdBarrier xcd_barrier_post(unsigned* bar, volatile LAS unsigned* st) {
    XcdBarrier b; b.bar = bar; b.x = xb_xcc_id(); b.st = st;
    if (threadIdx.x == 0) (void)xb_add(&bar[XB_XCNT(b.x)], 1u);
    return b;
}
DI void xcd_barrier_complete(unsigned* bar, unsigned x, unsigned& nloc, unsigned& nx) {
    const unsigned G = gridDim.x * gridDim.y * gridDim.z;
    unsigned sum, cnt, mine, sp = 0u;
    for (;;) {
        sum = 0u; cnt = 0u; mine = 0u;
#pragma unroll
        for (unsigned j = 0; j < 16; ++j) { const unsigned c = xb_ld(&bar[XB_XCNT(j)]); sum += c; cnt += (c > 0u) ? 1u : 0u; mine = (j == x) ? c : mine; }
        if (sum == G) break;
        __builtin_amdgcn_s_sleep(1);
        if ((++sp & 255u) == 0u) { if (xb_ld(&bar[XB_TMO])) break; if (sp > XB_SPIN_CAP) { atomicAdd(&bar[XB_TMO], 1u); break; } }
    }
    nloc = mine > 0u ? mine : 1u; nx = cnt > 0u ? cnt : 1u;
}
DI void xcd_barrier(const XcdBarrier& b) {
    asm volatile("s_waitcnt vmcnt(0)" ::: "memory");
    __syncthreads();
    if (threadIdx.x == 0) {
        unsigned* bar = b.bar;
        __builtin_amdgcn_s_waitcnt(0);
        unsigned nloc = b.st[0], nx = b.st[1];
        if (nloc == 0u) { xcd_barrier_complete(bar, b.x, nloc, nx); b.st[0] = nloc; b.st[1] = nx; }
        const unsigned old = xb_add(&bar[XB_XSUB(b.x)], 1u);
        const unsigned gen = old / nloc;
        if (old + 1u == (gen + 1u) * nloc) {
            __builtin_amdgcn_fence(__ATOMIC_RELEASE, "agent");
            asm volatile("s_waitcnt vmcnt(0)" ::: "memory");
            const unsigned og = xb_add(&bar[XB_TOP], 1u);
            const unsigned tg = og / nx;
            if (og + 1u == (tg + 1u) * nx) xb_add(&bar[XB_TOPGEN], 1u);
            else XB_SPIN(xb_ld(&bar[XB_TOPGEN]) == tg, bar);
            __builtin_amdgcn_fence(__ATOMIC_ACQUIRE, "agent");
            xb_add(&bar[XB_XGEN(b.x)], 1u);
            asm volatile("s_waitcnt vmcnt(0)" ::: "memory");
        } else {
            XB_SPIN(xb_ld(&bar[XB_XGEN(b.x)]) == gen, bar);
            __builtin_amdgcn_fence(__ATOMIC_ACQUIRE, "agent");
            asm volatile("s_waitcnt vmcnt(0)" ::: "memory");
        }
    }
    __syncthreads();
}

namespace pg8 {
#define PG8_LAS __attribute__((address_space(3)))
constexpr int BM = 256, BK = 64, HALF = 128, HTB = HALF * BK * 2, STAGE_BYTES = 8 * HTB, NXCD = 8, WGM = 8;
__host__ __device__ __forceinline__ int lds_byte(int r, int c) { const int st = (r >> 4) * 2 + (c >> 5), rr = r & 15, cc = c & 31, ob = rr * 64 + cc * 2; return st * 1024 + (ob ^ (((ob >> 9) & 1) << 5)); }
__host__ __device__ __forceinline__ void stage_rc(int b, int& R, int& C) { const int st = b / 1024, sb = b % 1024, swz = sb ^ (((sb >> 9) & 1) << 5); R = (st >> 1) * 16 + swz / 64; C = (st & 1) * 32 + (swz % 64) / 2; }
__host__ __device__ __forceinline__ int perm32(int rho) { const int n = rho >> 4, i = rho & 15; return 8 * (i >> 2) + 4 * n + (i & 3); }
struct Unit { int pm, pn; };
struct Gemm { const bf16_t* A; const bf16_t* Bt; int M, N, K; };
struct StaticOrder {
    int nM, nN, nwg, G, c;
    __host__ __device__ void init(int M, int N, int G_, int c_) { nM = M / BM; nN = N / BM; nwg = nM * nN; G = G_; c = c_; }
    __host__ __device__ bool next(int i, Unit& u) const {
        const long L = (long)i * G + c; if (L >= nwg) return false;
        int wgid = (int)L; { const int q = nwg / NXCD, r = nwg % NXCD, xcd = wgid % NXCD, off = wgid / NXCD; wgid = (xcd < r ? xcd * (q + 1) : r * (q + 1) + (xcd - r) * q) + off; }
        const int nig = WGM * nN, gid = wgid / nig, fm = gid * WGM, gsz = (nM - fm) < WGM ? (nM - fm) : WGM;
        u.pm = fm + ((wgid % nig) % gsz); u.pn = (wgid % nig) / gsz; return true;
    }
    __device__ __forceinline__ void a_ready(const Unit&) const {}
    __device__ __forceinline__ void done(const Unit&) const {}
};

template <class Epi, class Sched>
__device__ __forceinline__ void gemm_phase(PG8_LAS unsigned char* lds, const Gemm g, const Sched& S, const Epi& E) {
    const int tid = opq_tid(), wid = __builtin_amdgcn_readfirstlane(tid >> 6), lane = tid & 63, wr = wid >> 2, wc = wid & 3, fr = lane & 15, fq = lane >> 4;
    const int K = g.K, nt = K / BK;
    unsigned voffA[2], voffB[2];
#pragma unroll
    for (int i = 0; i < 2; ++i) { int R, C; stage_rc(tid * 16 + i * 8192, R, C); const int Rb = Epi::PERM ? ((R & ~31) + perm32(R & 31)) : R;
        voffA[i] = (unsigned)(R * K + C) * 2u; voffB[i] = (unsigned)(Rb * K + C) * 2u; }
    const size_t kstep = (size_t)(BK * 2);
    const size_t hstep = (size_t)HALF * K * 2;
    const size_t tstep = 2 * hstep;
    const unsigned ldsw = (unsigned)wid * 1024u;
    const int aoff = lds_byte(wr * 64 + fr, fq * 8), boff = lds_byte(wc * 32 + fr, fq * 8);
#define PG8_SA(b, h) (((b) * 2 + (h)) * HTB)
#define PG8_SB(b, h) ((4 + (b) * 2 + (h)) * HTB)
#define PG8_STAGE(bufoff, gbase, voff) do { _Pragma("unroll") for (int _i = 0; _i < 2; ++_i) \
        __builtin_amdgcn_global_load_lds((const unsigned*)((const char*)(gbase) + (voff)[_i]), (PG8_LAS unsigned*)(lds + (bufoff) + ldsw + _i * 8192), 16, 0, 0); } while (0)
#define PG8_LDA(dst, b, h) do { _Pragma("unroll") for (int m = 0; m < 4; ++m) _Pragma("unroll") for (int k = 0; k < 2; ++k) dst[m][k] = *(const PG8_LAS bf16x8*)(lds + PG8_SA(b, h) + aoff + m * 2048 + k * 1024); } while (0)
#define PG8_LDB(dst, b, h) do { _Pragma("unroll") for (int n = 0; n < 2; ++n) _Pragma("unroll") for (int k = 0; k < 2; ++k) dst[n][k] = *(const PG8_LAS bf16x8*)(lds + PG8_SB(b, h) + boff + n * 2048 + k * 1024); } while (0)
#define PG8_MMA(ai, bj, At, Bt) do { __builtin_amdgcn_s_setprio(1); _Pragma("unroll") for (int m = 0; m < 4; ++m) _Pragma("unroll") for (int n = 0; n < 2; ++n) _Pragma("unroll") for (int k = 0; k < 2; ++k) \
        acc[ai][bj][m][n] = __builtin_amdgcn_mfma_f32_16x16x32_bf16(Bt[n][k], At[m][k], acc[ai][bj][m][n], 0, 0, 0); __builtin_amdgcn_s_setprio(0); } while (0)
#define PG8_WAIT_V(n) asm volatile("s_waitcnt vmcnt(" #n ")" ::: "memory")
#define PG8_WAIT_L(n) asm volatile("s_waitcnt lgkmcnt(" #n ")" ::: "memory")
#define PG8_BAR __builtin_amdgcn_s_barrier()
#define PG8_SCHED __builtin_amdgcn_sched_barrier(0)
    Unit cur, nxt; int ui = 0;
    if (!S.next(0, cur)) return;
    f32x4 acc[2][2][4][2];
#pragma unroll
    for (int a = 0; a < 2; ++a)
#pragma unroll
        for (int b = 0; b < 2; ++b)
#pragma unroll
            for (int m = 0; m < 4; ++m)
#pragma unroll
                for (int n = 0; n < 2; ++n) acc[a][b][m][n] = (f32x4){0.f, 0.f, 0.f, 0.f};
    bf16x8 At[4][2], B0[2][2], B1[2][2];
    const char* cA = (const char*)g.A + (size_t)cur.pm * tstep; const char* cB = (const char*)g.Bt + (size_t)cur.pn * tstep;
    S.a_ready(cur);
    PG8_STAGE(PG8_SB(0, 0), cB, voffB); PG8_STAGE(PG8_SA(0, 0), cA, voffA); PG8_STAGE(PG8_SB(0, 1), cB + hstep, voffB); PG8_STAGE(PG8_SA(0, 1), cA + hstep, voffA);
    if (wr == 1) PG8_BAR;
    PG8_WAIT_V(4); PG8_BAR;
    PG8_STAGE(PG8_SB(1, 0), cB + kstep, voffB); PG8_STAGE(PG8_SA(1, 0), cA + kstep, voffA); PG8_STAGE(PG8_SB(1, 1), cB + hstep + kstep, voffB);
    PG8_WAIT_V(6); PG8_BAR;
    for (;;) {
        const bool has_next = S.next(ui + 1, nxt);
        const char* nA = has_next ? (const char*)g.A + (size_t)nxt.pm * tstep : cA; const char* nB = has_next ? (const char*)g.Bt + (size_t)nxt.pn * tstep : cB;
        for (int t = 0; t < nt; t += 2) {
            const bool last = (t == nt - 2);
            const char* a1 = cA + (size_t)(t + 1) * kstep;
            const char* a2 = last ? nA : cA + (size_t)(t + 2) * kstep; const char* b2 = last ? nB : cB + (size_t)(t + 2) * kstep;
            const char* a3 = a2 + kstep; const char* b3 = b2 + kstep;
            if (last && has_next) S.a_ready(nxt);
            PG8_LDB(B0, 0, 0); PG8_SCHED; PG8_LDA(At, 0, 0); PG8_STAGE(PG8_SA(1, 1), a1 + hstep, voffA);
            PG8_WAIT_L(8); PG8_BAR; PG8_WAIT_L(0); PG8_MMA(0, 0, At, B0); PG8_BAR; PG8_SCHED;
            PG8_LDB(B1, 0, 1); PG8_STAGE(PG8_SB(0, 0), b2, voffB);
            PG8_BAR; PG8_WAIT_L(0); PG8_MMA(0, 1, At, B1); PG8_BAR;
            PG8_LDA(At, 0, 1); PG8_STAGE(PG8_SA(0, 0), a2, voffA);
            PG8_BAR; PG8_WAIT_L(0); PG8_MMA(1, 0, At, B0); PG8_BAR; PG8_SCHED;
            PG8_STAGE(PG8_SB(0, 1), b2 + hstep, voffB);
            PG8_WAIT_V(6); PG8_BAR; PG8_MMA(1, 1, At, B1); PG8_BAR;
            PG8_LDB(B0, 1, 0); PG8_SCHED; PG8_LDA(At, 1, 0); PG8_STAGE(PG8_SA(0, 1), a2 + hstep, voffA);
            PG8_WAIT_L(8); PG8_BAR; PG8_WAIT_L(0); PG8_MMA(0, 0, At, B0); PG8_BAR; PG8_SCHED;
            PG8_LDB(B1, 1, 1); PG8_STAGE(PG8_SB(1, 0), b3, voffB);
            PG8_BAR; PG8_WAIT_L(0); PG8_MMA(0, 1, At, B1); PG8_BAR;
            PG8_LDA(At, 1, 1); PG8_STAGE(PG8_SA(1, 0), a3, voffA);
            PG8_BAR; PG8_WAIT_L(0); PG8_MMA(1, 0, At, B0); PG8_BAR; PG8_SCHED;
            PG8_STAGE(PG8_SB(1, 1), b3 + hstep, voffB);
            PG8_WAIT_V(6); PG8_BAR; PG8_MMA(1, 1, At, B1); PG8_BAR;
        }
        E(acc, cur, wr, wc, fr, fq); S.done(cur);
        if (!has_next) break;
#pragma unroll
        for (int a = 0; a < 2; ++a)
#pragma unroll
            for (int b = 0; b < 2; ++b)
#pragma unroll
                for (int m = 0; m < 4; ++m)
#pragma unroll
                    for (int n = 0; n < 2; ++n) acc[a][b][m][n] = (f32x4){0.f, 0.f, 0.f, 0.f};
        cur = nxt; cA = nA; cB = nB; ++ui;
    }
    PG8_WAIT_V(0);
    if (wr == 0) PG8_BAR;
    PG8_BAR;
#undef PG8_SA
#undef PG8_SB
#undef PG8_STAGE
#undef PG8_LDA
#undef PG8_LDB
#undef PG8_MMA
#undef PG8_WAIT_V
#undef PG8_WAIT_L
#undef PG8_BAR
#undef PG8_SCHED
}
}

typedef f32x4 AccT[2][2][4][2];
DI void store8(bf16_t* p, f32x4 a, f32x4 b) { u32x4 w = {cvt_pk_bf16(a[0], a[1]), cvt_pk_bf16(a[2], a[3]), cvt_pk_bf16(b[0], b[1]), cvt_pk_bf16(b[2], b[3])}; *(u32x4*)p = w; }
DI f32x4 silu4(f32x4 v) { f32x4 r; r[0] = silu_f(v[0]); r[1] = silu_f(v[1]); r[2] = silu_f(v[2]); r[3] = silu_f(v[3]); return r; }

struct EpiAttnIn {
    static constexpr bool PERM = true;
    bf16_t* q; bf16_t* sg; bf16_t* kb; bf16_t* vb;
    DI void operator()(const AccT& acc, const pg8::Unit& u, int wr, int wc, int fr, int fq) const {
        const int pn = u.pn, pm = u.pm, lrow0 = wr * 64 + fr, cl = wc * 32 + 8 * fq;
        if (pn < 8) {
            bf16_t* dst = (pn < 4 ? q : sg) + (pn & 3) * 256 + cl; const bool act = pn >= 4;
#pragma unroll
            for (int ai = 0; ai < 2; ++ai)
#pragma unroll
                for (int m = 0; m < 4; ++m) { const size_t row = (size_t)pm * 256 + lrow0 + ai * 128 + m * 16;
#pragma unroll
                    for (int bj = 0; bj < 2; ++bj) { f32x4 v0 = acc[ai][bj][m][0], v1 = acc[ai][bj][m][1]; if (act) { v0 = silu4(v0); v1 = silu4(v1); }
                        store8(dst + row * 1024 + bj * 128, v0, v1); } }
        } else {
            bf16_t* dst = (pn == 8 ? kb : vb) + cl;
            const int kvbase = pm < 128 ? (pm >> 4) * KVS + (pm & 15) * 256 : (pm - 128) * KVS + SEQ;
#pragma unroll
            for (int ai = 0; ai < 2; ++ai)
#pragma unroll
                for (int m = 0; m < 4; ++m) { const size_t row = (size_t)kvbase + lrow0 + ai * 128 + m * 16;
#pragma unroll
                    for (int bj = 0; bj < 2; ++bj) store8(dst + row * 256 + bj * 128, acc[ai][bj][m][0], acc[ai][bj][m][1]); }
        }
    }
};
struct EpiRetIn {
    static constexpr bool PERM = true;
    bf16_t* q; bf16_t* k; bf16_t* v; const h16x2* rope;
    DI void operator()(const AccT& acc, const pg8::Unit& u, int wr, int wc, int fr, int fq) const {
        const int pn = u.pn, pm = u.pm, lrow0 = wr * 64 + fr, cl = wc * 32 + 8 * fq;
        if (pn < 8) {
            bf16_t* dst = (pn < 4 ? q : k) + (pn & 3) * 256 + cl; const float scl = pn < 4 ? 1.f : 0.0625f;
            h16x8 cs[2][4][2];
#pragma unroll
            for (int ai = 0; ai < 2; ++ai)
#pragma unroll
                for (int m = 0; m < 4; ++m) { const int row = pm * 256 + lrow0 + ai * 128 + m * 16;
                    const int pos = pm < 128 ? CTXL + (row & (SEQ - 1)) : (row & (CTXL - 1));
                    const h16x8* rp = (const h16x8*)(rope + (size_t)pos * 128 + cl);
                    cs[ai][m][0] = rp[0]; cs[ai][m][1] = rp[1]; }
#pragma unroll
            for (int ai = 0; ai < 2; ++ai)
#pragma unroll
                for (int m = 0; m < 4; ++m) { const int row = pm * 256 + lrow0 + ai * 128 + m * 16;
                    f32x4 o1[2], o2[2];
#pragma unroll
                    for (int n = 0; n < 2; ++n) { const h16x8 c8 = cs[ai][m][n];
                        const f32x4 x1 = acc[ai][0][m][n], x2 = acc[ai][1][m][n];
#pragma unroll
                        for (int e = 0; e < 4; ++e) { const float c = (float)c8[2 * e], sn = (float)c8[2 * e + 1];
                            o1[n][e] = (x1[e] * c - x2[e] * sn) * scl; o2[n][e] = (x1[e] * sn + x2[e] * c) * scl; } }
                    store8(dst + (size_t)row * 1024, o1[0], o1[1]); store8(dst + (size_t)row * 1024 + 128, o2[0], o2[1]); }
        } else {
            bf16_t* dst = v + (pn - 8) * 256 + cl;
#pragma unroll
            for (int ai = 0; ai < 2; ++ai)
#pragma unroll
                for (int m = 0; m < 4; ++m) { const size_t row = (size_t)pm * 256 + lrow0 + ai * 128 + m * 16;
#pragma unroll
                    for (int bj = 0; bj < 2; ++bj) store8(dst + row * 2048 + bj * 128, acc[ai][bj][m][0], acc[ai][bj][m][1]); }
        }
    }
};
struct EpiGN {
    static constexpr bool PERM = true;
    bf16_t* o; const float* stats; const float* gn;
    DI void operator()(const AccT& acc, const pg8::Unit& u, int wr, int wc, int fr, int fq) const {
        const int col0 = u.pn * 256 + wc * 32 + 8 * fq, head = u.pn >> 1;
        f32x4 g0[2], g1[2];
#pragma unroll
        for (int bj = 0; bj < 2; ++bj) { g0[bj] = *(const f32x4*)(gn + col0 + bj * 128); g1[bj] = *(const f32x4*)(gn + col0 + bj * 128 + 4); }
#pragma unroll
        for (int ai = 0; ai < 2; ++ai) {
            float2 st[4]; u32x4 ov[4][2];
#pragma unroll
            for (int m = 0; m < 4; ++m) { const size_t row = (size_t)u.pm * 256 + wr * 64 + fr + ai * 128 + m * 16;
                st[m] = *(const float2*)(stats + (row * 4 + head) * 2);
#pragma unroll
                for (int bj = 0; bj < 2; ++bj) ov[m][bj] = *(const u32x4*)(o + row * 2048 + col0 + bj * 128); }
#pragma unroll
            for (int m = 0; m < 4; ++m) { const size_t row = (size_t)u.pm * 256 + wr * 64 + fr + ai * 128 + m * 16;
                const float mean = st[m].x * (1.f / 512.f), var = fmaxf(st[m].y * (1.f / 512.f) - mean * mean, 0.f), rstd = rsqrtf(var + 1e-5f);
#pragma unroll
                for (int bj = 0; bj < 2; ++bj) { bf16_t* op = o + row * 2048 + col0 + bj * 128; const u32x4 w = ov[m][bj];
                    const f32x4 s0 = silu4(acc[ai][bj][m][0]), s1 = silu4(acc[ai][bj][m][1]);
                    f32x4 y0, y1;
                    y0[0] = (bflo(w[0]) - mean) * rstd * g0[bj][0] * s0[0]; y0[1] = (bfhi(w[0]) - mean) * rstd * g0[bj][1] * s0[1];
                    y0[2] = (bflo(w[1]) - mean) * rstd * g0[bj][2] * s0[2]; y0[3] = (bfhi(w[1]) - mean) * rstd * g0[bj][3] * s0[3];
                    y1[0] = (bflo(w[2]) - mean) * rstd * g1[bj][0] * s1[0]; y1[1] = (bfhi(w[2]) - mean) * rstd * g1[bj][1] * s1[1];
                    y1[2] = (bflo(w[3]) - mean) * rstd * g1[bj][2] * s1[2]; y1[3] = (bfhi(w[3]) - mean) * rstd * g1[bj][3] * s1[3];
                    store8(op, y0, y1); } } }
    }
};
struct EpiPlain {
    static constexpr bool PERM = true;
    bf16_t* o; int ldc;
    DI void operator()(const AccT& acc, const pg8::Unit& u, int wr, int wc, int fr, int fq) const {
        bf16_t* dst = o + u.pn * 256 + wc * 32 + 8 * fq;
#pragma unroll
        for (int ai = 0; ai < 2; ++ai)
#pragma unroll
            for (int m = 0; m < 4; ++m) { const size_t row = (size_t)u.pm * 256 + wr * 64 + fr + ai * 128 + m * 16;
#pragma unroll
                for (int bj = 0; bj < 2; ++bj) store8(dst + row * ldc + bj * 128, acc[ai][bj][m][0], acc[ai][bj][m][1]); }
    }
};

namespace at {
constexpr int D = 128, NW = 8, QBLK = 32, KVBLK = 64;
constexpr float SCALE = 0.088388347648318440f;
constexpr float THR = 8.f;
constexpr int LDQ = 1024, LDK = 256;
constexpr size_t SHM_V = KVBLK * D * 2, SHM_K = KVBLK * D * 2, SHM_ATTN = 2 * SHM_V + 2 * SHM_K + NW * 64 * 4;
#define KSWZ(row, colB) ((row) * 256 + ((colB) ^ (((row) & 7) << 4)))
#define SBAR() __builtin_amdgcn_sched_barrier(0)
DI int crow(int r, int hi) { return (r & 3) + 8 * (r >> 2) + 4 * hi; }
DI unsigned cvtpk(float lo, float hi) { unsigned r; asm volatile("v_cvt_pk_bf16_f32 %0, %1, %2" : "=v"(r) : "v"(lo), "v"(hi)); return r; }
DI bf16x8 ld8(const bf16_t* p) { return *reinterpret_cast<const bf16x8*>(p); }

DI void partialSM(f32x16& p0, f32x16& p1, float& m_reg, float& mn, float& alpha) {
  constexpr float C = SCALE * 1.4426950408889634f;
  float pmax = p0[0]; for (int r = 1; r < 16; ++r) pmax = fmaxf(pmax, p0[r]); for (int r = 0; r < 16; ++r) pmax = fmaxf(pmax, p1[r]);
  { auto rr = __builtin_amdgcn_permlane32_swap(__float_as_uint(pmax), __float_as_uint(pmax), false, false);
    pmax = fmaxf(__uint_as_float(rr[0]), __uint_as_float(rr[1])); }
  if (__builtin_expect(__all(pmax - m_reg <= THR / SCALE), 1)) { mn = m_reg; alpha = 1.f; }
  else { mn = fmaxf(m_reg, pmax); alpha = __builtin_amdgcn_exp2f((m_reg - mn) * C); m_reg = mn; }
  float mnC = -mn * C;
  for (int r = 0; r < 16; ++r) p0[r] = fmaf(p0[r], C, mnC); for (int r = 0; r < 16; ++r) p1[r] = fmaf(p1[r], C, mnC);
  for (int r = 0; r < 16; ++r) p0[r] = __builtin_amdgcn_exp2f(p0[r]);
}
DI void finishSM(f32x16& p0, f32x16& p1, float alpha, float& l_reg, bf16x8& pa0, bf16x8& pa1, bf16x8& pa2, bf16x8& pa3) {
  for (int r = 0; r < 16; ++r) p1[r] = __builtin_amdgcn_exp2f(p1[r]);
  float ps = 0; for (int r = 0; r < 16; ++r) ps += p0[r]; for (int r = 0; r < 16; ++r) ps += p1[r];
  { auto rr = __builtin_amdgcn_permlane32_swap(__float_as_uint(ps), __float_as_uint(ps), false, false);
    ps = __uint_as_float(rr[0]) + __uint_as_float(rr[1]); }
  l_reg = l_reg * alpha + ps;
#define PK4(P, BASE, OUT) do { unsigned a0 = cvtpk(P[BASE + 0], P[BASE + 1]), a1 = cvtpk(P[BASE + 2], P[BASE + 3]);   \
    unsigned b0 = cvtpk(P[BASE + 4], P[BASE + 5]), b1 = cvtpk(P[BASE + 6], P[BASE + 7]);                              \
    auto r0 = __builtin_amdgcn_permlane32_swap(a0, b0, false, false); auto r1 = __builtin_amdgcn_permlane32_swap(a1, b1, false, false); \
    u32x4 w = {r0[0], r1[0], r0[1], r1[1]}; OUT = *reinterpret_cast<bf16x8*>(&w); } while (0)
  PK4(p0, 0, pa0); PK4(p0, 8, pa1); PK4(p1, 0, pa2); PK4(p1, 8, pa3);
#undef PK4
}
DI void qkt(f32x16& p0, f32x16& p1, const bf16_t* Ks, const bf16x8* qr, int r32, int hi) {
  p0 = f32x16{}; p1 = f32x16{};
  for (int d0 = 0; d0 < 8; ++d0) { int cb = (d0 * 16 + hi * 8) * 2;
    bf16x8 b0 = *reinterpret_cast<const bf16x8*>((const char*)Ks + KSWZ(r32, cb));
    bf16x8 b1 = *reinterpret_cast<const bf16x8*>((const char*)Ks + KSWZ(32 + r32, cb));
    p0 = __builtin_amdgcn_mfma_f32_32x32x16_bf16(b0, qr[d0], p0, 0, 0, 0);
    p1 = __builtin_amdgcn_mfma_f32_32x32x16_bf16(b1, qr[d0], p1, 0, 0, 0); }
}
DI int v_st(int k, int c) { const int kk = (k & ~0xC) | ((k & 4) << 1) | ((k & 8) >> 1); return ((kk >> 3) * 4 + (c >> 5)) * 512 + ((kk & 7) * 32 + (c & 31)) * 2; }
DI int v_rd_base(int lane) { return ((lane & 3) << 3) | (((lane >> 2) & 3) << 6) | (((lane >> 4) & 1) << 5) | (((lane >> 5) & 1) << 8); }
constexpr int v_rd_off(int d0, int ks, int half) { return d0 * 512 + ks * 4096 + half * 2048; }
template <int OFF> DI s16x4 tr_read(int vb) {
  s16x4 r; asm volatile("ds_read_b64_tr_b16 %0, %1 offset:%2" : "=&v"(r) : "v"(vb), "i"(OFF) : "memory"); return r;
}
template <int D0> DI void pv_one(f32x16& od, int vb, bf16x8 pa0, bf16x8 pa1, bf16x8 pa2, bf16x8 pa3) {
  const s16x4 l0 = tr_read<v_rd_off(D0, 0, 0)>(vb), h0 = tr_read<v_rd_off(D0, 0, 1)>(vb), l1 = tr_read<v_rd_off(D0, 1, 0)>(vb), h1 = tr_read<v_rd_off(D0, 1, 1)>(vb);
  const s16x4 l2 = tr_read<v_rd_off(D0, 2, 0)>(vb), h2 = tr_read<v_rd_off(D0, 2, 1)>(vb), l3 = tr_read<v_rd_off(D0, 3, 0)>(vb), h3 = tr_read<v_rd_off(D0, 3, 1)>(vb);
  asm volatile("s_waitcnt lgkmcnt(0)" ::: "memory"); SBAR();
#define PK(L, H) (bf16x8){L[0], L[1], L[2], L[3], H[0], H[1], H[2], H[3]}
  od = __builtin_amdgcn_mfma_f32_32x32x16_bf16(pa0, PK(l0, h0), od, 0, 0, 0);
  od = __builtin_amdgcn_mfma_f32_32x32x16_bf16(pa1, PK(l1, h1), od, 0, 0, 0);
  od = __builtin_amdgcn_mfma_f32_32x32x16_bf16(pa2, PK(l2, h2), od, 0, 0, 0);
  od = __builtin_amdgcn_mfma_f32_32x32x16_bf16(pa3, PK(l3, h3), od, 0, 0, 0);
#undef PK
}
DI void pv_d0(f32x16* o, int vb, bf16x8 pa0, bf16x8 pa1, bf16x8 pa2, bf16x8 pa3) {
  pv_one<0>(o[0], vb, pa0, pa1, pa2, pa3); pv_one<1>(o[1], vb, pa0, pa1, pa2, pa3); pv_one<2>(o[2], vb, pa0, pa1, pa2, pa3); pv_one<3>(o[3], vb, pa0, pa1, pa2, pa3);
}
DI void attn_dense_body(const bf16_t* __restrict__ Qb, const bf16_t* __restrict__ Kh, const bf16_t* __restrict__ Vh,
                        const bf16_t* __restrict__ Gb, bf16_t* __restrict__ Ob, int seq, char* lds,
                        const float* __restrict__ qsc, const float2* __restrict__ ropeA, int rope_t0) {
  const int tid = opq_tid(), wid = tid >> 6, lane = tid & 63, r32 = lane & 31, hi = lane >> 5;
  bf16_t* V_lds = (bf16_t*)lds; bf16_t* K_lds = (bf16_t*)(lds + 2 * SHM_V);
  float* ws = (float*)(lds + 2 * SHM_V + 2 * SHM_K) + wid * 64; float* li_l = ws; float* al_l = ws + 32;
  float m_reg = -1e30f, l_reg = 0; f32x16 o[4] = {}; bf16x8 qr[8];
  const bf16_t* Qw = Qb + (long)(wid * QBLK + r32) * LDQ + hi * 8;
#pragma unroll
  for (int d0 = 0; d0 < 8; ++d0) qr[d0] = ld8(Qw + d0 * 16);
  {
    float xf[8][8]; float ss = 0.f;
#pragma unroll
    for (int d0 = 0; d0 < 8; ++d0) { const u32x4 w = *reinterpret_cast<const u32x4*>(&qr[d0]);
#pragma unroll
      for (int i = 0; i < 4; ++i) { xf[d0][2 * i] = bflo(w[i]); xf[d0][2 * i + 1] = bfhi(w[i]); ss += xf[d0][2 * i] * xf[d0][2 * i] + xf[d0][2 * i + 1] * xf[d0][2 * i + 1]; } }
    { auto rr = __builtin_amdgcn_permlane32_swap(__float_as_uint(ss), __float_as_uint(ss), false, false); ss = __uint_as_float(rr[0]) + __uint_as_float(rr[1]); }
    const float rinv = rsqrtf(ss * (1.f / 128.f) + 1e-6f);
#pragma unroll
    for (int d0 = 0; d0 < 8; ++d0) { const f32x4 s0 = *(const f32x4*)(qsc + d0 * 16 + hi * 8), s1 = *(const f32x4*)(qsc + d0 * 16 + hi * 8 + 4);
#pragma unroll
      for (int e = 0; e < 4; ++e) { xf[d0][e] *= rinv * s0[e]; xf[d0][4 + e] *= rinv * s1[e]; } }
    if (rope_t0 >= 0) { const int t = rope_t0 + wid * QBLK + r32;
#pragma unroll
      for (int half = 0; half < 2; ++half) { const int pos = half ? (t & 63) : (t >> 6);
#pragma unroll
        for (int dp = 0; dp < 2; ++dp) { const f32x4* cp = (const f32x4*)(ropeA + pos * 32 + dp * 16 + hi * 8);
#pragma unroll
          for (int e2 = 0; e2 < 4; ++e2) { const f32x4 cs = cp[e2];
            const int da = half * 4 + dp, db = da + 2;
            float x1 = xf[da][2 * e2], x2 = xf[db][2 * e2]; xf[da][2 * e2] = x1 * cs[0] - x2 * cs[1]; xf[db][2 * e2] = x1 * cs[1] + x2 * cs[0];
            x1 = xf[da][2 * e2 + 1]; x2 = xf[db][2 * e2 + 1]; xf[da][2 * e2 + 1] = x1 * cs[2] - x2 * cs[3]; xf[db][2 * e2 + 1] = x1 * cs[3] + x2 * cs[2]; } } } }
#pragma unroll
    for (int d0 = 0; d0 < 8; ++d0) { u32x4 w = {cvtpk(xf[d0][0], xf[d0][1]), cvtpk(xf[d0][2], xf[d0][3]), cvtpk(xf[d0][4], xf[d0][5]), cvtpk(xf[d0][6], xf[d0][7])}; qr[d0] = *reinterpret_cast<bf16x8*>(&w); }
  }
  const int sr = tid >> 4, sc = (tid & 15) * 8, vst0 = v_st(sr, sc), vst1 = v_st(32 + sr, sc);
  const int vb0 = (int)(uintptr_t)V_lds + v_rd_base(lane);
  struct { bf16x8 vs0, vs1, ks0, ks1; } sr_[2];
#define SLOAD(i, k0) do { sr_[i].vs0 = ld8(&Vh[(long)((k0) + sr) * LDK + sc]); sr_[i].vs1 = ld8(&Vh[(long)((k0) + 32 + sr) * LDK + sc]); \
    sr_[i].ks0 = ld8(&Kh[(long)((k0) + sr) * LDK + sc]); sr_[i].ks1 = ld8(&Kh[(long)((k0) + 32 + sr) * LDK + sc]); } while (0)
#define SWRITE(b, i) do { *(bf16x8*)((char*)V_lds + (b) * SHM_V + vst0) = sr_[i].vs0;          \
    *(bf16x8*)((char*)V_lds + (b) * SHM_V + vst1) = sr_[i].vs1; int kc = sc * 2;               \
    *(bf16x8*)((char*)K_lds + (b) * SHM_K + KSWZ(sr, kc)) = sr_[i].ks0;                       \
    *(bf16x8*)((char*)K_lds + (b) * SHM_K + KSWZ(32 + sr, kc)) = sr_[i].ks1; } while (0)
#define SWAIT() asm volatile("s_waitcnt vmcnt(4)" ::: "memory")
#define RESC(a) do { if (__any((a) < 1.f)) { if (hi == 0) al_l[r32] = (a); asm volatile("s_waitcnt lgkmcnt(0)" ::: "memory"); \
    for (int d = 0; d < 4; ++d) for (int r = 0; r < 16; ++r) o[d][r] *= al_l[crow(r, hi)]; } } while (0)
  f32x16 pA0, pA1, pB0, pB1; float mnA, mnB, alA, alB; bf16x8 pa0, pa1, pa2, pa3; const int NT = seq / KVBLK;
  constexpr int SE = 0, SO = 1;
  SLOAD(SE, 0); asm volatile("s_waitcnt vmcnt(0)" ::: "memory"); SWRITE(0, SE); __syncthreads();
  qkt(pA0, pA1, K_lds, qr, r32, hi); partialSM(pA0, pA1, m_reg, mnA, alA);
  SLOAD(SO, KVBLK); if (2 < NT) SLOAD(SE, 2 * KVBLK);
  SWAIT(); SWRITE(1, SO); __syncthreads();
  for (int j = 1; j + 1 < NT; j += 2) {
    SBAR(); qkt(pB0, pB1, (bf16_t*)((char*)K_lds + SHM_K), qr, r32, hi);
    finishSM(pA0, pA1, alA, l_reg, pa0, pa1, pa2, pa3); SBAR();
    SLOAD(SO, (j + 2) * KVBLK); SBAR();
    pv_d0(o, vb0, pa0, pa1, pa2, pa3); partialSM(pB0, pB1, m_reg, mnB, alB);
    __syncthreads(); SWAIT(); SWRITE(0, SE);
    RESC(alB); __syncthreads();
    SBAR(); qkt(pA0, pA1, K_lds, qr, r32, hi);
    finishSM(pB0, pB1, alB, l_reg, pa0, pa1, pa2, pa3); SBAR();
    if (j + 3 < NT) SLOAD(SE, (j + 3) * KVBLK); SBAR();
    pv_d0(o, vb0 + (int)SHM_V, pa0, pa1, pa2, pa3); partialSM(pA0, pA1, m_reg, mnA, alA);
    __syncthreads(); SWAIT(); SWRITE(1, SO);
    RESC(alA); __syncthreads();
  }
  SBAR(); qkt(pB0, pB1, (bf16_t*)((char*)K_lds + SHM_K), qr, r32, hi);
  finishSM(pA0, pA1, alA, l_reg, pa0, pa1, pa2, pa3); SBAR();
  pv_d0(o, vb0, pa0, pa1, pa2, pa3); partialSM(pB0, pB1, m_reg, mnB, alB);
  __syncthreads(); RESC(alB);
  finishSM(pB0, pB1, alB, l_reg, pa0, pa1, pa2, pa3); SBAR();
  pv_d0(o, vb0 + (int)SHM_V, pa0, pa1, pa2, pa3);
  if (hi == 0) li_l[r32] = l_reg; asm volatile("s_waitcnt lgkmcnt(0)" ::: "memory");
  float rli[16];
#pragma unroll
  for (int r = 0; r < 16; ++r) rli[r] = __builtin_amdgcn_rcpf(li_l[crow(r, hi)]);
  u32x4 gv[8];
#pragma unroll
  for (int it = 0; it < 8; ++it) gv[it] = *(const u32x4*)(Gb + (long)((tid >> 4) + 32 * it) * LDQ + (tid & 15) * 8);
  __syncthreads();
  bf16_t* stg = (bf16_t*)lds;
#pragma unroll
  for (int r = 0; r < 16; ++r) { bf16_t* sp = stg + (wid * QBLK + crow(r, hi)) * 136 + r32;
    sp[0] = f2bf(o[0][r] * rli[r]); sp[32] = f2bf(o[1][r] * rli[r]); sp[64] = f2bf(o[2][r] * rli[r]); sp[96] = f2bf(o[3][r] * rli[r]); }
  __syncthreads();
#pragma unroll
  for (int it = 0; it < 8; ++it) { const int row = (tid >> 4) + 32 * it, c8 = (tid & 15) * 8;
    const u32x4 ov = *(const u32x4*)(stg + row * 136 + c8);
    f32x4 y0, y1;
    y0[0] = bflo(ov[0]) * bflo(gv[it][0]); y0[1] = bfhi(ov[0]) * bfhi(gv[it][0]); y0[2] = bflo(ov[1]) * bflo(gv[it][1]); y0[3] = bfhi(ov[1]) * bfhi(gv[it][1]);
    y1[0] = bflo(ov[2]) * bflo(gv[it][2]); y1[1] = bfhi(ov[2]) * bfhi(gv[it][2]); y1[2] = bflo(ov[3]) * bflo(gv[it][3]); y1[3] = bfhi(ov[3]) * bfhi(gv[it][3]);
    store8(Ob + (long)row * LDQ + c8, y0, y1); }
#undef SLOAD
#undef SWRITE
#undef SWAIT
#undef RESC
  __syncthreads();
}
}

DI void mod_phase(const Args& a, float* ldsf) {
    const int tid = opq_tid();
    float* modv = (float*)(a.ws + OFF_MOD);
    if ((int)blockIdx.x >= 192) return;
    const float* c = a.in[1]; const float* cc = a.in[3];
    for (int i = tid; i < 9 * 1024; i += NTHREADS) { const int bb = i >> 10, k = i & 1023; const float v = bb < 8 ? c[bb * 1024 + k] : cc[k]; ldsf[i] = v / (1.f + expf(-v)); }
    __syncthreads();
    float* red = ldsf + 9 * 1024;
    for (int item = blockIdx.x; item < 192; item += gridDim.x) {
        const int l = item / 48, cgp = item % 48, cj = tid & 63, ks = tid >> 6, col = cgp * 64 + cj;
        float acc[9];
#pragma unroll
        for (int bb = 0; bb < 9; ++bb) acc[bb] = 0.f;
        const float* W = a.in[4] + (size_t)l * 1024 * 3072 + col;
        for (int k0 = ks * 128; k0 < ks * 128 + 128; k0 += 16) {
            float w[16];
#pragma unroll
            for (int u = 0; u < 16; ++u) w[u] = W[(size_t)(k0 + u) * 3072];
#pragma unroll
            for (int u = 0; u < 16; ++u) {
#pragma unroll
                for (int bb = 0; bb < 9; ++bb) acc[bb] = fmaf(ldsf[bb * 1024 + k0 + u], w[u], acc[bb]); } }
#pragma unroll
        for (int bb = 0; bb < 9; ++bb) red[(ks * 9 + bb) * 64 + cj] = acc[bb];
        __syncthreads();
        for (int i = tid; i < 9 * 64; i += NTHREADS) { const int bb = i >> 6, cj2 = i & 63; float s = 0.f;
#pragma unroll
            for (int k2 = 0; k2 < 8; ++k2) s += red[(k2 * 9 + bb) * 64 + cj2];
            const int col2 = cgp * 64 + cj2; modv[(size_t)(l * 9 + bb) * 3072 + col2] = s + a.in[5][l * 3072 + col2]; }
        __syncthreads();
    }
}
DI float2 cs_f64(double ang) {
    const double kq = rint(ang * 0.63661977236758134308);
    double r = fma(-kq, 1.57079632679489655800e+00, ang); r = fma(-kq, 6.12323399573676603587e-17, r);
    const double r2 = r * r;
    double sn = r * (1.0 + r2 * (-1.0 / 6 + r2 * (1.0 / 120 + r2 * (-1.0 / 5040 + r2 * (1.0 / 362880 + r2 * (-1.0 / 39916800 + r2 * (1.0 / 6227020800.0)))))));
    double cn = 1.0 + r2 * (-0.5 + r2 * (1.0 / 24 + r2 * (-1.0 / 720 + r2 * (1.0 / 40320 + r2 * (-1.0 / 3628800 + r2 * (1.0 / 479001600 + r2 * (-1.0 / 87178291200.0)))))));
    const int q = ((int)kq) & 3;
    double cc = (q == 0) ? cn : (q == 1) ? -sn : (q == 2) ? -cn : sn;
    double ss = (q == 0) ? sn : (q == 1) ? cn : (q == 2) ? -sn : -cn;
    return make_float2((float)cc, (float)ss);
}
DI void rope_phase(const Args& a) {
    h16x2* rr = (h16x2*)(a.ws + OFF_ROPER); float2* ra = (float2*)(a.ws + OFF_ROPEA);
    const int gt = blockIdx.x * NTHREADS + opq_tid(), gs = gridDim.x * NTHREADS;
    for (int i = gt; i < KVS * 128 + 64 * 32; i += gs) {
        if (i < KVS * 128) { const int pos = i >> 7, f = i & 127; const double fr = exp(-(double)f * (9.21034037197618273607 / 128.0)); const float2 v = cs_f64((double)pos * fr); h16x2 hv = {(_Float16)v.x, (_Float16)v.y}; rr[i] = hv; }
        else { const int j = i - KVS * 128, pos = j >> 5, f = j & 31; const double fr = exp(-(double)f * (9.21034037197618273607 / 32.0)); ra[j] = cs_f64((double)pos * fr); }
    }
}
DI void convert_wt(const float* __restrict__ W, bf16_t* __restrict__ Wt, int K, int N, float* tl) {
    const int tid = opq_tid(), ntn = N / 64, ntiles = (K / 64) * ntn;
    for (int tile = blockIdx.x; tile < ntiles; tile += gridDim.x) {
        const int k0 = (tile / ntn) * 64, n0 = (tile % ntn) * 64, tj = tid & 63, ti = tid >> 6;
#pragma unroll
        for (int ii = 0; ii < 8; ++ii) { const int k = ti * 8 + ii; tl[k * 65 + tj] = W[(size_t)(k0 + k) * N + n0 + tj]; }
        __syncthreads();
        const int n = tid >> 3, ks = (tid & 7) * 8;
        u32x4 w;
        w[0] = cvt_pk_bf16(tl[(ks + 0) * 65 + n], tl[(ks + 1) * 65 + n]); w[1] = cvt_pk_bf16(tl[(ks + 2) * 65 + n], tl[(ks + 3) * 65 + n]);
        w[2] = cvt_pk_bf16(tl[(ks + 4) * 65 + n], tl[(ks + 5) * 65 + n]); w[3] = cvt_pk_bf16(tl[(ks + 6) * 65 + n], tl[(ks + 7) * 65 + n]);
        *(u32x4*)(Wt + (size_t)(n0 + n) * K + k0 + ks) = w;
        __syncthreads();
    }
}
DI void convert_layer_weights(const Args& a, int l, float* tl) {
    bf16_t* wt = (bf16_t*)(a.ws + OFF_WT); const int j = l >> 1;
    if ((l & 1) == 0) { convert_wt(a.in[8] + (size_t)j * 1024 * ATT_IN, wt, 1024, ATT_IN, tl); convert_wt(a.in[9] + (size_t)j * 1024 * 1024, wt + (size_t)ATT_IN * 1024, 1024, 1024, tl); }
    else { convert_wt(a.in[12] + (size_t)j * 1024 * RET_IN, wt, 1024, RET_IN, tl); convert_wt(a.in[13] + (size_t)j * 2048 * 1024, wt + (size_t)RET_IN * 1024, 2048, 1024, tl); }
}
DI void modulate_phase(const Args& a) {
    const float* modv = (const float*)(a.ws + OFF_MOD); bf16_t* h = (bf16_t*)(a.ws + OFF_H);
    const int gt = blockIdx.x * NTHREADS + opq_tid();
    if (gt >= 1024 * 128) return;
    const int c8 = (gt & 127) * 8, r0 = gt >> 7;
#pragma unroll 1
    for (int g = 0; g < 9; ++g) {
        const int nr = g < 8 ? 4 : 2;
        const float* mv = modv + (size_t)g * 3072;
        const f32x4 sh0 = *(const f32x4*)(mv + c8), sh1 = *(const f32x4*)(mv + c8 + 4), sc0 = *(const f32x4*)(mv + 1024 + c8) + 1.f, sc1 = *(const f32x4*)(mv + 1024 + c8 + 4) + 1.f;
        f32x4 x0[4], x1[4];
#pragma unroll
        for (int k = 0; k < 4; ++k) { const int kk = k < nr ? k : 0; const int row = g * 4096 + r0 + 1024 * kk;
            const float* xr = row < TL ? a.in[0] + (size_t)row * 1024 : a.in[2] + (size_t)(row - TL) * 1024;
            x0[k] = *(const f32x4*)(xr + c8); x1[k] = *(const f32x4*)(xr + c8 + 4); }
#pragma unroll
        for (int k = 0; k < 4; ++k) { if (k < nr) { const int row = g * 4096 + r0 + 1024 * k;
            store8(h + (size_t)row * 1024 + c8, x0[k] * sc0 + sh0, x1[k] * sc1 + sh1); } }
    }
}
template <int NR>
DI void ln_rows(const Args& a, int l, int row0, int lane, const f32x4 (&lgv)[4], const f32x4 (&lbv)[4], const f32x4 (&gate)[4], const f32x4 (&sh)[4], const f32x4 (&sc1)[4]) {
    bf16_t* h = (bf16_t*)(a.ws + OFF_H); float* zc = (float*)(a.ws + OFF_CTXR); const bf16_t* y = (const bf16_t*)(a.ws + OFF_R1);
    const float* xlat = l == 0 ? a.in[0] : a.out; const float* xctx = l == 0 ? a.in[2] : zc;
    f32x4 v[NR][4]; float s[NR];
#pragma unroll
    for (int k = 0; k < NR; ++k) { const int row = row0 + k; s[k] = 0.f;
        const float* xr = row < TL ? xlat + (size_t)row * 1024 : xctx + (size_t)(row - TL) * 1024;
#pragma unroll
        for (int i = 0; i < 4; ++i) { const int col = 4 * lane + 256 * i;
            const f32x4 xv = *(const f32x4*)(xr + col); const u32x2 yw = *(const u32x2*)(y + (size_t)row * 1024 + col);
            f32x4 yv; yv[0] = bflo(yw[0]); yv[1] = bfhi(yw[0]); yv[2] = bflo(yw[1]); yv[3] = bfhi(yw[1]);
            v[k][i] = xv * ALPHA + gate[i] * yv; s[k] += v[k][i][0] + v[k][i][1] + v[k][i][2] + v[k][i][3]; } }
    float mean[NR], rstd[NR];
#pragma unroll
    for (int k = 0; k < NR; ++k) mean[k] = wave_sum(s[k]) * (1.f / 1024.f);
#pragma unroll
    for (int k = 0; k < NR; ++k) { float q = 0.f;
#pragma unroll
        for (int i = 0; i < 4; ++i) { v[k][i] = v[k][i] - mean[k]; q += v[k][i][0] * v[k][i][0] + v[k][i][1] * v[k][i][1] + v[k][i][2] * v[k][i][2] + v[k][i][3] * v[k][i][3]; }
        rstd[k] = rsqrtf(wave_sum(q) * (1.f / 1024.f) + 1e-5f); }
#pragma unroll
    for (int k = 0; k < NR; ++k) { const int row = row0 + k;
        float* zr = row < TL ? a.out + (size_t)row * 1024 : zc + (size_t)(row - TL) * 1024;
#pragma unroll
        for (int i = 0; i < 4; ++i) { const int col = 4 * lane + 256 * i;
            const f32x4 yo = v[k][i] * rstd[k] * lgv[i] + lbv[i];
            *(f32x4*)(zr + col) = yo;
            if (l < 3) { const f32x4 hv = yo * sc1[i] + sh[i]; u32x2 w = {cvt_pk_bf16(hv[0], hv[1]), cvt_pk_bf16(hv[2], hv[3])}; *(u32x2*)(h + (size_t)row * 1024 + col) = w; } } }
}
DI void ln_phase(const Args& a, int l) {
    const float* lg = a.in[6] + l * 1024; const float* lb = a.in[7] + l * 1024;
    const float* modl = (const float*)(a.ws + OFF_MOD) + (size_t)l * 9 * 3072;
    const float* modn = modl + 9 * 3072;
    const int tid_ = opq_tid(), lane = tid_ & 63, wid = tid_ >> 6;
    f32x4 lgv[4], lbv[4], gate[4], sh[4], sc1[4];
#pragma unroll
    for (int i = 0; i < 4; ++i) { const int col = 4 * lane + 256 * i; lgv[i] = *(const f32x4*)(lg + col); lbv[i] = *(const f32x4*)(lb + col); }
    for (int gw = blockIdx.x * 8 + wid; gw < TL / 16; gw += gridDim.x * 8) {
        const int bb = gw >> 8;
#pragma unroll
        for (int i = 0; i < 4; ++i) { const int col = 4 * lane + 256 * i; gate[i] = *(const f32x4*)(modl + bb * 3072 + 2048 + col);
            sh[i] = *(const f32x4*)(modn + bb * 3072 + col); sc1[i] = *(const f32x4*)(modn + bb * 3072 + 1024 + col) + 1.f; }
#pragma unroll 1
        for (int r0 = 0; r0 < 16; r0 += 2) ln_rows<2>(a, l, gw * 16 + r0, lane, lgv, lbv, gate, sh, sc1);
    }
    if (l < 3) {
#pragma unroll
        for (int i = 0; i < 4; ++i) { const int col = 4 * lane + 256 * i; gate[i] = *(const f32x4*)(modl + 8 * 3072 + 2048 + col);
            sh[i] = *(const f32x4*)(modn + 8 * 3072 + col); sc1[i] = *(const f32x4*)(modn + 8 * 3072 + 1024 + col) + 1.f; }
        for (int gw = blockIdx.x * 8 + wid; gw < TC; gw += gridDim.x * 8) ln_rows<1>(a, l, TL + gw, lane, lgv, lbv, gate, sh, sc1);
    }
}
DI void attn_normrope_phase(const Args& a, int j) {
    bf16_t* kb = (bf16_t*)(a.ws + OFF_R3);
    const float2* ra = (const float2*)(a.ws + OFF_ROPEA);
    const float* ksc = a.in[11] + j * 128;
    const int tid_ = opq_tid(), lane = tid_ & 63, wid = tid_ >> 6, half = lane >> 5, i = lane & 31, e1 = half * 64 + i, e2 = e1 + 32;
    const float ks1 = ksc[e1], ks2 = ksc[e2];
    const int stride = gridDim.x * 8;
    constexpr int NRK = 4;
    for (int row0 = blockIdx.x * 8 + wid; row0 < TT; row0 += NRK * stride) {
        float x1[NRK][2], x2[NRK][2], cs[NRK], sn[NRK]; bf16_t* kp[NRK];
#pragma unroll
        for (int k = 0; k < NRK; ++k) { const int row = row0 + k * stride < TT ? row0 + k * stride : row0;
            const bool lat = row < TL; const int t = row & (SEQ - 1);
            cs[k] = 1.f; sn[k] = 0.f;
            if (lat) { const int pos = half ? (t & 63) : (t >> 6); const float2 v = ra[pos * 32 + i]; cs[k] = v.x; sn[k] = v.y; }
            const size_t kr = lat ? (size_t)(row >> 12) * KVS + t : (size_t)((row - TL) >> 8) * KVS + SEQ + (row & (CTXL - 1));
            kp[k] = kb + kr * 256;
#pragma unroll
            for (int hk = 0; hk < 2; ++hk) { x1[k][hk] = bf2f(kp[k][hk * 128 + e1]); x2[k][hk] = bf2f(kp[k][hk * 128 + e2]); } }
#pragma unroll
        for (int k = 0; k < NRK; ++k) { if (row0 + k * stride < TT) {
#pragma unroll
            for (int hh = 0; hh < 2; ++hh) {
                const float ss = wave_sum(x1[k][hh] * x1[k][hh] + x2[k][hh] * x2[k][hh]);
                const float rinv = rsqrtf(ss * (1.f / 128.f) + 1e-6f);
                const float y1 = x1[k][hh] * rinv * ks1, y2 = x2[k][hh] * rinv * ks2;
                kp[k][hh * 128 + e1] = f2bf(y1 * cs[k] - y2 * sn[k]); kp[k][hh * 128 + e2] = f2bf(y1 * sn[k] + y2 * cs[k]);
            } } }
    }
}
DI void attn_phase(const Args& a, int j, char* lds) {
    const bf16_t* q = (const bf16_t*)(a.ws + OFF_R1); const bf16_t* sg = (const bf16_t*)(a.ws + OFF_R2);
    const bf16_t* kb = (const bf16_t*)(a.ws + OFF_R3); const bf16_t* vb = kb + (size_t)NB * KVS * 256;
    bf16_t* ao = (bf16_t*)(a.ws + OFF_R4);
    const int c = blockIdx.x, G = gridDim.x;
    for (int u = c; u < 1024 + 64; u += G) {
        int b, h, row0, seq; size_t kvoff;
        if (u < 1024) {
            int pair, idx;
            if (G == 256) { const int rnd = u >> 8, cc = u & 255, xcd = cc & 7, slot = cc >> 3; pair = rnd * 4 + (xcd >> 1); idx = (xcd & 1) * 32 + slot; }
            else { pair = u >> 6; idx = u & 63; }
            b = pair >> 1; const int kvh = pair & 1; h = kvh * 4 + (idx >> 4); const int qb = idx & 15;
            row0 = b * SEQ + qb * 256; seq = KVS; kvoff = (size_t)b * KVS * 256 + kvh * 128;
        } else {
            const int v = u - 1024; b = v >> 3; h = v & 7; row0 = TL + b * CTXL; seq = CTXL; kvoff = ((size_t)b * KVS + SEQ) * 256 + (h >> 2) * 128;
        }
        const size_t qoff = (size_t)row0 * 1024 + h * 128;
        at::attn_dense_body(q + qoff, kb + kvoff, vb + kvoff, sg + qoff, ao + qoff, seq, lds, a.in[10] + j * 128, (const float2*)(a.ws + OFF_ROPEA), u < 1024 ? (row0 & (SEQ - 1)) : -1);
    }
}

namespace rt {
constexpr int C = 64;
constexpr int QRS = 528, KRS = 544, VRS = 160, PRS = 144;
constexpr int Q_OFF = 0, K_OFF = Q_OFF + 64 * QRS, V_OFF = K_OFF + 64 * KRS, P_OFF = V_OFF + 64 * VRS, X_OFF = P_OFF + 64 * PRS, S_OFF = X_OFF + 8 * 2048, SRS = 68 * 4, LDS_END = S_OFF + 64 * SRS;
static_assert(LDS_END <= LDS_MAIN && QRS == 528, "scan LDS");
DI int prow(int k) { return (k & ~12) | ((k & 4) << 1) | ((k & 8) >> 1); }
template <int OFF> DI s16x4 tr_rd(unsigned addr) { s16x4 r; asm volatile("ds_read_b64_tr_b16 %0, %1 offset:%2" : "=&v"(r) : "v"(addr), "i"(OFF) : "memory"); return r; }
DI bf16x8 cat(s16x4 l, s16x4 h) { return (bf16x8){l[0], l[1], l[2], l[3], h[0], h[1], h[2], h[3]}; }
template <int OFF> DI s16x4 rd64(unsigned addr) { s16x4 r; asm volatile("ds_read_b64 %0, %1 offset:%2" : "=&v"(r) : "v"(addr), "i"(OFF) : "memory"); return r; }
template <int S> DI void qs_load(bf16x8 (&d)[4], unsigned qb) {
    const s16x4 l0 = rd64<0 * 16 * 528 + S * 64>(qb), h0 = rd64<0 * 16 * 528 + S * 64 + 32>(qb), l1 = rd64<1 * 16 * 528 + S * 64>(qb), h1 = rd64<1 * 16 * 528 + S * 64 + 32>(qb);
    const s16x4 l2 = rd64<2 * 16 * 528 + S * 64>(qb), h2 = rd64<2 * 16 * 528 + S * 64 + 32>(qb), l3 = rd64<3 * 16 * 528 + S * 64>(qb), h3 = rd64<3 * 16 * 528 + S * 64 + 32>(qb);
    d[0] = cat(l0, h0); d[1] = cat(l1, h1); d[2] = cat(l2, h2); d[3] = cat(l3, h3);
}
#define MFMA16(a, b, c) __builtin_amdgcn_mfma_f32_16x16x32_bf16((a), (b), (c), 0, 0, 0)
#define RT_CB() do { asm volatile("" ::: "memory"); __builtin_amdgcn_sched_barrier(0); } while (0)
#define RT_LGKM(n) do { asm volatile("s_waitcnt lgkmcnt(" #n ")" ::: "memory"); __builtin_amdgcn_sched_barrier(0); } while (0)
template <int FWD> DI int chunk_row(int step, int b) {
    if (FWD) return step < 4 ? TL + b * CTXL + 64 * step : b * SEQ + 64 * (step - 4);
    return step < 4 ? TL + b * CTXL + 64 * (3 - step) : b * SEQ + 64 * (67 - step);
}
struct KT8 { s16x4 a0, a1, a2, a3, b0, b1, b2, b3; };
template <int T0> DI void kt_load(KT8& k, unsigned kb) {
    k.a0 = tr_rd<T0 * 32>(kb); k.a1 = tr_rd<T0 * 32 + 8 * KRS>(kb); k.a2 = tr_rd<T0 * 32 + 32 * KRS>(kb); k.a3 = tr_rd<T0 * 32 + 40 * KRS>(kb);
    k.b0 = tr_rd<T0 * 32 + 32>(kb); k.b1 = tr_rd<T0 * 32 + 32 + 8 * KRS>(kb); k.b2 = tr_rd<T0 * 32 + 32 + 32 * KRS>(kb); k.b3 = tr_rd<T0 * 32 + 32 + 40 * KRS>(kb);
}
DI void kt_mma(f32x4& sa, f32x4& sb, const KT8& k, bf16x8 vz0, bf16x8 vz1) {
    sa = MFMA16(cat(k.a0, k.a1), vz0, sa); sa = MFMA16(cat(k.a2, k.a3), vz1, sa);
    sb = MFMA16(cat(k.b0, k.b1), vz0, sb); sb = MFMA16(cat(k.b2, k.b3), vz1, sb);
}
}

namespace rt {
constexpr int V2RS = 288, S2RS = 132;
constexpr int V2_OFF = K_OFF + 64 * KRS, P2_OFF = V2_OFF + 64 * V2RS, S2_OFF = P2_OFF + 64 * PRS, LDS2_END = S2_OFF + 64 * S2RS * 4;
static_assert(LDS2_END <= LDS_MAIN, "scan2 LDS");
template <int FWD, class BarrierFn>
DI void scan2_dir(const bf16_t* __restrict__ Qg, const bf16_t* __restrict__ Kg, bf16_t* Vg, bf16_t* Tg, bf16_t* TCB, float* stats, int b, int h, int sl, float lg, char* lds, const BarrierFn& gbar) {
    const int tid = opq_tid(), wid = __builtin_amdgcn_readfirstlane(tid >> 6), lane = tid & 63, c = lane & 15, g = lane >> 4;
    const unsigned lb = (unsigned)(uintptr_t)lds;
    const int kt = wid >> 1, qt0 = 2 * (wid & 1);
    const size_t qkcol = (size_t)h * 256, vcol = (size_t)h * 512 + sl * 128;
    const int trrow = 16 * (g >> 1) + 4 * (g & 1) + (c >> 2);
    const unsigned kb_tr = lb + K_OFF + trrow * KRS + (4 * (c & 3)) * 2;
    const unsigned vb_tr = lb + V2_OFF + trrow * V2RS + (16 * wid + 4 * (c & 3)) * 2;
    const char* ks_rd = lds + K_OFF + (16 * kt + prow(c)) * KRS + 16 * g;
    const char* q0_rd = lds + Q_OFF + (16 * qt0 + c) * QRS + 16 * g;
    const unsigned qs_b = lb + Q_OFF + c * QRS + (4 * g) * 2;
    const char* p_rd = lds + P2_OFF + c * PRS + (8 * g) * 2;
    const float lg2 = lg * 1.4426950408889634f;
    const float gC = exp2f(lg2 * 64.f);
    float wm[4], zt0[8], zt1[8];
#pragma unroll
    for (int jj = 0; jj < 4; ++jj) { const int m = 16 * kt + 4 * g + jj; wm[jj] = exp2f(-lg2 * (float)(FWD ? m + 1 : 64 - m)); }
#pragma unroll
    for (int jj = 0; jj < 8; ++jj) { const int m = 8 * g + jj; zt0[jj] = exp2f(lg2 * (float)(64 - (FWD ? m + 1 : 64 - m))); zt1[jj] = exp2f(lg2 * (float)(64 - (FWD ? m + 33 : 32 - m))); }
    const int srow = tid >> 4, scp = tid & 15;
    const float xi0 = exp2f(lg2 * (float)(FWD ? srow + 1 : 64 - srow)), xi1 = exp2f(lg2 * (float)(FWD ? srow + 33 : 32 - srow));
    f32x4 st[16];
#pragma unroll
    for (int t = 0; t < 16; ++t) st[t] = (f32x4){0.f, 0.f, 0.f, 0.f};
    bf16x8 pq[4], pk[4], pv[2];
    float* stg_w = (float*)(lds + S2_OFF) + (4 * g) * S2RS + 16 * wid + c;
    const float* stg_r = (const float*)(lds + S2_OFF) + srow * S2RS + scp * 8;
#define R2_LOAD(rb) do { _Pragma("unroll") for (int i_ = 0; i_ < 4; ++i_) { const int p_ = tid + 512 * i_, r_ = p_ >> 5, cp_ = p_ & 31; \
        pq[i_] = *(const bf16x8*)(Qg + (size_t)((rb) + r_) * 1024 + qkcol + cp_ * 8); pk[i_] = *(const bf16x8*)(Kg + (size_t)((rb) + r_) * 1024 + qkcol + cp_ * 8); } \
        pv[0] = *(const bf16x8*)(Vg + (size_t)((rb) + srow) * 2048 + vcol + scp * 8); pv[1] = *(const bf16x8*)(Vg + (size_t)((rb) + srow + 32) * 2048 + vcol + scp * 8); } while (0)
#define R2_WRITE() do { _Pragma("unroll") for (int i_ = 0; i_ < 4; ++i_) { const int p_ = tid + 512 * i_, r_ = p_ >> 5, cp_ = p_ & 31; \
        *(bf16x8*)(lds + Q_OFF + r_ * QRS + cp_ * 16) = pq[i_]; *(bf16x8*)(lds + K_OFF + prow(r_) * KRS + cp_ * 16) = pk[i_]; } \
        *(bf16x8*)(lds + V2_OFF + prow(srow) * V2RS + scp * 16) = pv[0]; *(bf16x8*)(lds + V2_OFF + prow(srow + 32) * V2RS + scp * 16) = pv[1]; } while (0)
    R2_LOAD(chunk_row<FWD>(0, b)); R2_WRITE(); __syncthreads();
    for (int step = 0; step < 68; ++step) {
        if (step == 36) gbar();
        const int rb = chunk_row<FWD>(step, b);
        const bool fin = step >= 36;
        if (step + 1 < 68) { const int rbn = chunk_row<FWD>(step + 1, b); R2_LOAD(rbn); }
        bf16x8 tv0 = {}, tv1 = {};
        if (fin) { tv0 = *(const bf16x8*)(Tg + (size_t)(rb + srow) * 2048 + vcol + scp * 8); tv1 = *(const bf16x8*)(Tg + (size_t)(rb + srow + 32) * 2048 + vcol + scp * 8); }
        {
            f32x4 s0 = {0.f, 0.f, 0.f, 0.f}, s1 = {0.f, 0.f, 0.f, 0.f};
            bf16x8 ak[2], aq0[2], aq1[2], bk[2], bq0[2], bq1[2];
#define ST_LOAD(K_, Q0_, Q1_, S_) do { _Pragma("unroll") for (int i_ = 0; i_ < 2; ++i_) { K_[i_] = *(const bf16x8*)(ks_rd + 64 * ((S_) + i_)); \
                Q0_[i_] = *(const bf16x8*)(q0_rd + 64 * ((S_) + i_)); Q1_[i_] = *(const bf16x8*)(q0_rd + 16 * QRS + 64 * ((S_) + i_)); } RT_CB(); } while (0)
#define ST_MMA(K_, Q0_, Q1_) do { _Pragma("unroll") for (int i_ = 0; i_ < 2; ++i_) { s0 = MFMA16(K_[i_], Q0_[i_], s0); s1 = MFMA16(K_[i_], Q1_[i_], s1); } RT_CB(); } while (0)
            ST_LOAD(ak, aq0, aq1, 0); ST_LOAD(bk, bq0, bq1, 2);
            ST_MMA(ak, aq0, aq1); ST_LOAD(ak, aq0, aq1, 4);
            ST_MMA(bk, bq0, bq1); ST_LOAD(bk, bq0, bq1, 6);
            ST_MMA(ak, aq0, aq1); ST_MMA(bk, bq0, bq1);
#undef ST_LOAD
#undef ST_MMA
            const int n0 = 16 * qt0 + c, n1 = n0 + 16, mb = 16 * kt + 4 * g;
            float p0[4], p1[4];
#pragma unroll
            for (int jj = 0; jj < 4; ++jj) { const int m = mb + jj; const float wmv = wm[jj];
                const bool k0 = FWD ? (m <= n0) : (m > n0), k1 = FWD ? (m <= n1) : (m > n1);
                p0[jj] = k0 ? s0[jj] * wmv : 0.f; p1[jj] = k1 ? s1[jj] * wmv : 0.f; }
            u32x2 w0 = {cvt_pk_bf16(p0[0], p0[1]), cvt_pk_bf16(p0[2], p0[3])}, w1 = {cvt_pk_bf16(p1[0], p1[1]), cvt_pk_bf16(p1[2], p1[3])};
            *(u32x2*)(lds + P2_OFF + n0 * PRS + mb * 2) = w0; *(u32x2*)(lds + P2_OFF + n1 * PRS + mb * 2) = w1;
        }
        f32x4 o[4];
#pragma unroll
        for (int nt = 0; nt < 4; ++nt) o[nt] = (f32x4){0.f, 0.f, 0.f, 0.f};
        {
            bf16x8 qa[4], qb[4];
#define QS_MMA(D_, S_) do { u32x4 fw = {cvt_pk_bf16(st[2 * (S_)][0], st[2 * (S_)][1]), cvt_pk_bf16(st[2 * (S_)][2], st[2 * (S_)][3]), cvt_pk_bf16(st[2 * (S_) + 1][0], st[2 * (S_) + 1][1]), cvt_pk_bf16(st[2 * (S_) + 1][2], st[2 * (S_) + 1][3])}; \
            const bf16x8 sf = *reinterpret_cast<bf16x8*>(&fw); _Pragma("unroll") for (int nt = 0; nt < 4; ++nt) o[nt] = MFMA16(D_[nt], sf, o[nt]); } while (0)
            qs_load<0>(qa, qs_b); qs_load<1>(qb, qs_b);
            RT_LGKM(8); QS_MMA(qa, 0); qs_load<2>(qa, qs_b);
            RT_LGKM(8); QS_MMA(qb, 1); qs_load<3>(qb, qs_b);
            RT_LGKM(8); QS_MMA(qa, 2); qs_load<4>(qa, qs_b);
            RT_LGKM(8); QS_MMA(qb, 3); qs_load<5>(qb, qs_b);
            RT_LGKM(8); QS_MMA(qa, 4); qs_load<6>(qa, qs_b);
            RT_LGKM(8); QS_MMA(qb, 5); qs_load<7>(qb, qs_b);
            RT_LGKM(8); QS_MMA(qa, 6);
            RT_LGKM(0); QS_MMA(qb, 7);
#undef QS_MMA
        }
        bf16x8 vf0, vf1;
        {
            const s16x4 l0 = tr_rd<0>(vb_tr), h0 = tr_rd<8 * V2RS>(vb_tr), l1 = tr_rd<32 * V2RS>(vb_tr), h1 = tr_rd<40 * V2RS>(vb_tr);
            KT8 ka, kb2;
            kt_load<0>(ka, kb_tr);
            RT_LGKM(8);
            vf0 = cat(l0, h0); vf1 = cat(l1, h1);
            bf16x8 vz0, vz1;
            {
                float f[8];
#pragma unroll
                for (int jj = 0; jj < 8; ++jj) f[jj] = bf2f((bf16_t)vf0[jj]) * zt0[jj];
                u32x4 w = {cvt_pk_bf16(f[0], f[1]), cvt_pk_bf16(f[2], f[3]), cvt_pk_bf16(f[4], f[5]), cvt_pk_bf16(f[6], f[7])};
                vz0 = *reinterpret_cast<bf16x8*>(&w);
#pragma unroll
                for (int jj = 0; jj < 8; ++jj) f[jj] = bf2f((bf16_t)vf1[jj]) * zt1[jj];
                u32x4 w2 = {cvt_pk_bf16(f[0], f[1]), cvt_pk_bf16(f[2], f[3]), cvt_pk_bf16(f[4], f[5]), cvt_pk_bf16(f[6], f[7])};
                vz1 = *reinterpret_cast<bf16x8*>(&w2);
            }
#pragma unroll
            for (int t = 0; t < 16; ++t) st[t] = st[t] * gC;
            kt_load<2>(kb2, kb_tr);  RT_LGKM(8); kt_mma(st[0], st[1], ka, vz0, vz1);
            kt_load<4>(ka, kb_tr);   RT_LGKM(8); kt_mma(st[2], st[3], kb2, vz0, vz1);
            kt_load<6>(kb2, kb_tr);  RT_LGKM(8); kt_mma(st[4], st[5], ka, vz0, vz1);
            kt_load<8>(ka, kb_tr);   RT_LGKM(8); kt_mma(st[6], st[7], kb2, vz0, vz1);
            kt_load<10>(kb2, kb_tr); RT_LGKM(8); kt_mma(st[8], st[9], ka, vz0, vz1);
            kt_load<12>(ka, kb_tr);  RT_LGKM(8); kt_mma(st[10], st[11], kb2, vz0, vz1);
            kt_load<14>(kb2, kb_tr); RT_LGKM(8); kt_mma(st[12], st[13], ka, vz0, vz1);
            RT_LGKM(0); kt_mma(st[14], st[15], kb2, vz0, vz1);
        }
        __syncthreads();
        {
            bf16x8 pa[4], pb[4];
#pragma unroll
            for (int nt = 0; nt < 4; ++nt) { pa[nt] = *(const bf16x8*)(p_rd + nt * 16 * PRS); pb[nt] = *(const bf16x8*)(p_rd + nt * 16 * PRS + 64); }
            RT_CB();
#pragma unroll
            for (int nt = 0; nt < 4; ++nt) { o[nt] = MFMA16(pa[nt], vf0, o[nt]); o[nt] = MFMA16(pb[nt], vf1, o[nt]); }
        }
#pragma unroll
        for (int nt = 0; nt < 4; ++nt)
#pragma unroll
            for (int r = 0; r < 4; ++r) stg_w[(nt * 16 + r) * S2RS] = o[nt][r];
        __syncthreads();
        if (step + 1 < 68) R2_WRITE();
        {
            bf16_t* dst = (fin ? Vg : ((!FWD && step < 4) ? TCB - (size_t)TL * 2048 : Tg));
#pragma unroll
            for (int hf = 0; hf < 2; ++hf) {
                const float* sr = stg_r + hf * 32 * S2RS; const float xi = hf ? xi1 : xi0;
                f32x4 b0 = *(const f32x4*)sr * xi, b1 = *(const f32x4*)(sr + 4) * xi;
                if (fin) { const bf16x8 tvv = hf ? tv1 : tv0; const u32x4 ow = *reinterpret_cast<const u32x4*>(&tvv);
                    b0[0] += bflo(ow[0]); b0[1] += bfhi(ow[0]); b0[2] += bflo(ow[1]); b0[3] += bfhi(ow[1]); b1[0] += bflo(ow[2]); b1[1] += bfhi(ow[2]); b1[2] += bflo(ow[3]); b1[3] += bfhi(ow[3]); }
                const size_t row = (size_t)(rb + srow + 32 * hf);
                store8(dst + row * 2048 + vcol + scp * 8, b0, b1);
                if (fin) {
                    float sm = (b0[0] + b0[1]) + (b0[2] + b0[3]) + (b1[0] + b1[1]) + (b1[2] + b1[3]);
                    float sq = (b0[0] * b0[0] + b0[1] * b0[1]) + (b0[2] * b0[2] + b0[3] * b0[3]) + (b1[0] * b1[0] + b1[1] * b1[1]) + (b1[2] * b1[2] + b1[3] * b1[3]);
#pragma unroll
                    for (int o_ = 1; o_ < 16; o_ <<= 1) { sm += __shfl_xor(sm, o_, 64); sq += __shfl_xor(sq, o_, 64); }
                    if (scp == 0) { float* sp = stats + (row * 4 + h) * 2; unsafeAtomicAdd(sp, sm); unsafeAtomicAdd(sp + 1, sq); }
                }
            }
        }
        __syncthreads();
    }
#undef R2_LOAD
#undef R2_WRITE
    if (FWD) {
        for (int p = tid; p < 4096; p += NTHREADS) { const int r = p >> 4, cp = p & 15; const size_t crow_ = (size_t)b * CTXL + r, row = TL + crow_;
            const u32x4 fa = *(const u32x4*)(Tg + row * 2048 + vcol + cp * 8), fb = *(const u32x4*)(TCB + crow_ * 2048 + vcol + cp * 8);
            f32x4 b0, b1;
            b0[0] = bflo(fa[0]) + bflo(fb[0]); b0[1] = bfhi(fa[0]) + bfhi(fb[0]); b0[2] = bflo(fa[1]) + bflo(fb[1]); b0[3] = bfhi(fa[1]) + bfhi(fb[1]);
            b1[0] = bflo(fa[2]) + bflo(fb[2]); b1[1] = bfhi(fa[2]) + bfhi(fb[2]); b1[2] = bflo(fa[3]) + bflo(fb[3]); b1[3] = bfhi(fa[3]) + bfhi(fb[3]);
            store8(Vg + row * 2048 + vcol + cp * 8, b0, b1);
            float sm = (b0[0] + b0[1]) + (b0[2] + b0[3]) + (b1[0] + b1[1]) + (b1[2] + b1[3]);
            float sq = (b0[0] * b0[0] + b0[1] * b0[1]) + (b0[2] * b0[2] + b0[3] * b0[3]) + (b1[0] * b1[0] + b1[1] * b1[1]) + (b1[2] * b1[2] + b1[3] * b1[3]);
#pragma unroll
            for (int o_ = 1; o_ < 16; o_ <<= 1) { sm += __shfl_xor(sm, o_, 64); sq += __shfl_xor(sq, o_, 64); }
            if (cp == 0) { float* sp = stats + (row * 4 + h) * 2; unsafeAtomicAdd(sp, sm); unsafeAtomicAdd(sp + 1, sq); }
        }
    }
}
}
template <class BarrierFn>
DI void scan_phase(const Args& a, int j, char* lds, const BarrierFn& gbar) {
    const bf16_t* Qg = (const bf16_t*)(a.ws + OFF_R1); const bf16_t* Kg = (const bf16_t*)(a.ws + OFF_R2);
    bf16_t* Vg = (bf16_t*)(a.ws + OFF_R3); bf16_t* OBg = (bf16_t*)(a.ws + OFF_R4); float* stats = (float*)(a.ws + OFF_STATS);
    if (gridDim.x == 256) {
        const int u = blockIdx.x, xcd = u & 7, slot = u >> 3, pair = xcd * 4 + (slot >> 3), idx = slot & 7, b = pair >> 2, h = pair & 3, dir = idx & 1, sl = idx >> 1;
        bf16_t* TCB = (bf16_t*)(a.ws + OFF_TCB);
        if (dir) rt::scan2_dir<1>(Qg, Kg, Vg, OBg, TCB, stats, b, h, sl, a.in[15][j * 4 + h], lds, gbar);
        else     rt::scan2_dir<0>(Qg, Kg, Vg, OBg, TCB, stats, b, h, sl, a.in[16][j * 4 + h], lds, gbar);
        return;
    }
    gbar();
}
DI void zero_stats(const Args& a) {
    float* stz = (float*)(a.ws + OFF_STATS);
    float z = 0.f; asm volatile("" : "+v"(z));
    const f32x4 zv = {z, z, z, z};
    for (int i = blockIdx.x * NTHREADS + opq_tid(); i < TT * 2; i += gridDim.x * NTHREADS) *(f32x4*)(stz + (size_t)i * 4) = zv;
}
__global__ void __launch_bounds__(NTHREADS, 2) fwd_megakernel(Args a) {
    extern __shared__ __attribute__((aligned(16))) unsigned char lds[];
    cg::grid_group grid = cg::this_grid();
    PG8_LAS unsigned char* ldsg = (PG8_LAS unsigned char*)lds;
    const int G = gridDim.x, bx = blockIdx.x;
    bf16_t* wt = (bf16_t*)(a.ws + OFF_WT);
    bf16_t* hbuf = (bf16_t*)(a.ws + OFF_H);
    bf16_t* r1 = (bf16_t*)(a.ws + OFF_R1); bf16_t* r2 = (bf16_t*)(a.ws + OFF_R2); bf16_t* r3 = (bf16_t*)(a.ws + OFF_R3); bf16_t* r4 = (bf16_t*)(a.ws + OFF_R4);

    { volatile LAS unsigned* bst = (volatile LAS unsigned*)((LAS unsigned char*)lds + LDS_MAIN);
      if (threadIdx.x < 4) bst[threadIdx.x] = 0u;
      __syncthreads();
      (void)xcd_barrier_post((unsigned*)(a.ws + OFF_BAR), bst); }
#define GSYNC() do { XcdBarrier xb_; xb_.bar = (unsigned*)(a.ws + OFF_BAR); xb_.x = xb_xcc_id(); xb_.st = (volatile LAS unsigned*)((LAS unsigned char*)lds + LDS_MAIN); xcd_barrier(xb_); } while (0)
    mod_phase(a, (float*)lds);
    __syncthreads();
    rope_phase(a);
    convert_layer_weights(a, 0, (float*)lds);
    if (a.ws == nullptr) grid.sync();
    GSYNC();
    modulate_phase(a);
    GSYNC();

    for (int l = 0; l < 4; ++l) {
        const int j = l >> 1;
        if ((l & 1) == 0) {
            { pg8::Gemm gm{hbuf, wt, TT, ATT_IN, 1024}; pg8::StaticOrder S; S.init(TT, ATT_IN, G, bx);
              EpiAttnIn E{r1, r2, r3, r3 + (size_t)NB * KVS * 256};
              pg8::gemm_phase<EpiAttnIn, pg8::StaticOrder>(ldsg, gm, S, E); }
            GSYNC();
            attn_normrope_phase(a, j);
            GSYNC();
            attn_phase(a, j, (char*)lds);
            GSYNC();
            { pg8::Gemm gm{r4, wt + (size_t)ATT_IN * 1024, TT, 1024, 1024}; pg8::StaticOrder S; S.init(TT, 1024, G, bx);
              EpiPlain E{r1, 1024};
              pg8::gemm_phase<EpiPlain, pg8::StaticOrder>(ldsg, gm, S, E); }
            GSYNC();
        } else {
            const int Mr = (l == 3) ? TL : TT;
            zero_stats(a);
            { pg8::Gemm gm{hbuf, wt, TT, 4096, 1024}; pg8::StaticOrder S; S.init(TT, 4096, G, bx);
              EpiRetIn E{r1, r2, r3, (const h16x2*)(a.ws + OFF_ROPER)};
              pg8::gemm_phase<EpiRetIn, pg8::StaticOrder>(ldsg, gm, S, E); }
            GSYNC();
            scan_phase(a, j, (char*)lds, [&]() { GSYNC(); });
            GSYNC();
            { pg8::Gemm gm{hbuf, wt + (size_t)4096 * 1024, Mr, 2048, 1024}; pg8::StaticOrder S; S.init(Mr, 2048, G, bx);
              EpiGN E{r3, (const float*)(a.ws + OFF_STATS), a.in[14] + (size_t)j * 2048};
              pg8::gemm_phase<EpiGN, pg8::StaticOrder>(ldsg, gm, S, E); }
            GSYNC();
            { pg8::Gemm gm{r3, wt + (size_t)RET_IN * 1024, Mr, 1024, 2048}; pg8::StaticOrder S; S.init(Mr, 1024, G, bx);
              EpiPlain E{r1, 1024};
              pg8::gemm_phase<EpiPlain, pg8::StaticOrder>(ldsg, gm, S, E); }
            GSYNC();
        }
        ln_phase(a, l);
        if (l < 3) { convert_layer_weights(a, l + 1, (float*)lds); GSYNC(); }
    }
}

extern "C" void kernel_launch(void* const* d_in, const int* in_sizes, int n_in, void* d_out, int out_size, void* d_ws, size_t ws_size, hipStream_t stream) {
    static int grid_blocks = 0;
    if (grid_blocks == 0) {
        if (n_in != 17 || out_size != TL * DM || ws_size < WS_END) { fprintf(stderr, "kernel_launch: unexpected shapes n_in %d out %d ws %zu (need %zu)\n", n_in, out_size, ws_size, (size_t)WS_END); grid_blocks = -1; return; }
        int dev = 0, cus = 0, per_cu = 0;
        hipGetDevice(&dev);
        hipDeviceGetAttribute(&cus, hipDeviceAttributeMultiprocessorCount, dev);
        if (hipFuncSetAttribute((const void*)fwd_megakernel, hipFuncAttributeMaxDynamicSharedMemorySize, LDS_BYTES) != hipSuccess) { fprintf(stderr, "kernel_launch: hipFuncSetAttribute failed\n"); grid_blocks = -1; return; }
        if (hipOccupancyMaxActiveBlocksPerMultiprocessor(&per_cu, (const void*)fwd_megakernel, NTHREADS, LDS_BYTES) != hipSuccess || per_cu < 1) { fprintf(stderr, "kernel_launch: occupancy query gave %d\n", per_cu); per_cu = 1; }
        (void)hipGetLastError();
        if (cus < 256) { fprintf(stderr, "kernel_launch: needs 256 CUs (one 512-thread workgroup each), device has %d\n", cus); grid_blocks = -1; return; }
        grid_blocks = 256;
    }
    if (grid_blocks < 0) return;
    if (hipMemsetAsync((char*)d_ws + OFF_BAR, 0, BAR_BYTES, stream) != hipSuccess) { fprintf(stderr, "kernel_launch: memset failed\n"); return; }
    Args a{};
    for (int i = 0; i < 17; ++i) a.in[i] = (const float*)d_in[i];
    a.out = (float*)d_out; a.ws = (unsigned char*)d_ws;
    void* args[] = {&a};
    hipError_t e = hipLaunchCooperativeKernel((const void*)fwd_megakernel, dim3(grid_blocks), dim3(NTHREADS), args, LDS_BYTES, stream);
    if (e != hipSuccess) fprintf(stderr, "kernel_launch: cooperative launch failed: %s (grid %d)\n", hipGetErrorString(e), grid_blocks);
}
```

```cpp
#include <hip/hip_runtime.h>
#include <hip/hip_cooperative_groups.h>
#include <cstdio>
#include <cstdint>
namespace cg = cooperative_groups;

typedef unsigned short bf16_t;
typedef short bf16x8 __attribute__((ext_vector_type(8)));
typedef short s16x4 __attribute__((ext_vector_type(4)));
typedef float f32x4 __attribute__((ext_vector_type(4)));
typedef float f32x16 __attribute__((ext_vector_type(16)));
typedef float f32x8 __attribute__((ext_vector_type(8)));
typedef unsigned u32x4 __attribute__((ext_vector_type(4)));
typedef unsigned u32x2 __attribute__((ext_vector_type(2)));
typedef _Float16 h16x2 __attribute__((ext_vector_type(2)));
typedef _Float16 h16x8 __attribute__((ext_vector_type(8)));

constexpr int DM = 1024, NB = 8, SEQ = 4096, CTXL = 256;
constexpr int TL = NB * SEQ, TC = NB * CTXL, TT = TL + TC;
constexpr int KVS = SEQ + CTXL;
constexpr int ATT_IN = 2560, RET_IN = 6144;
constexpr float ALPHA = 1.681792830507429f;
constexpr int NTHREADS = 512;
constexpr int LDS_MAIN = 131072;
constexpr int LDS_BYTES = LDS_MAIN + 16;

constexpr size_t SZ_T1K = (size_t)TT * 1024 * 2;
constexpr size_t OFF_WT = 0;
constexpr size_t OFF_MOD = OFF_WT + 16777216;
constexpr size_t OFF_ROPER = OFF_MOD + 442368;
constexpr size_t OFF_ROPEA = OFF_ROPER + 2228224;
constexpr size_t OFF_CTXR = OFF_ROPEA + 16384;
constexpr size_t OFF_H = OFF_CTXR + 8388608;
constexpr size_t OFF_R1 = OFF_H + SZ_T1K;
constexpr size_t OFF_R2 = OFF_R1 + SZ_T1K;
constexpr size_t OFF_R3 = OFF_R2 + SZ_T1K;
constexpr size_t OFF_R4 = OFF_R3 + 2 * SZ_T1K;
constexpr size_t OFF_BAR = OFF_R4 + 2 * SZ_T1K;
constexpr size_t BAR_BYTES = 16384;
constexpr size_t OFF_STATS = OFF_BAR + BAR_BYTES;
constexpr size_t STATS_BYTES = (size_t)TT * 4 * 2 * 4;
constexpr size_t OFF_TCB = OFF_STATS + STATS_BYTES;
constexpr size_t WS_END = OFF_TCB + (size_t)TC * 2048 * 2;
static_assert(WS_END <= 536870912, "workspace must fit 4x the largest tensor");

struct Args {
    const float* in[17];
    float* out;
    unsigned char* ws;
};

#define DI __device__ __forceinline__
DI int opq_tid() { int t = threadIdx.x; asm volatile("" : "+v"(t)); return t; }
DI unsigned cvt_pk_bf16(float lo, float hi) { unsigned r; asm volatile("v_cvt_pk_bf16_f32 %0, %1, %2" : "=v"(r) : "v"(lo), "v"(hi)); return r; }
DI float bf2f(bf16_t b) { return __uint_as_float(((unsigned)b) << 16); }
DI float bflo(unsigned w) { return __uint_as_float(w << 16); }
DI float bfhi(unsigned w) { return __uint_as_float(w & 0xffff0000u); }
DI bf16_t f2bf(float f) { return (bf16_t)(cvt_pk_bf16(f, f) & 0xffffu); }
DI float silu_f(float x) { return x * __builtin_amdgcn_rcpf(1.f + __expf(-x)); }
DI float wave_sum(float v) {
#pragma unroll
    for (int o = 32; o >= 1; o >>= 1) v += __shfl_xor(v, o, 64);
    return v;
}


#define XB_TMO      128
#define XB_XCNT(j)  (256  + 64 * (j))
#define XB_XSUB(j)  (1280 + 64 * (j))
#define XB_XGEN(j)  (2304 + 64 * (j))
#define XB_TOP      3328
#define XB_TOPGEN   3392
#define XCD_BAR_WORDS 3456
#define XB_SPIN_CAP (1u << 18)
#define LAS __attribute__((address_space(3)))
DI unsigned xb_ld(unsigned* p)              { return __hip_atomic_load(p, __ATOMIC_RELAXED, __HIP_MEMORY_SCOPE_AGENT); }
DI unsigned xb_add(unsigned* p, unsigned v) { return __hip_atomic_fetch_add(p, v, __ATOMIC_RELAXED, __HIP_MEMORY_SCOPE_AGENT); }
DI unsigned xb_xcc_id() { return (unsigned)__builtin_amdgcn_s_getreg((3 << 11) | 20) & 0xFu; }
#define XB_SPIN(cond, bar) do { unsigned _sp = 0; while (cond) { __builtin_amdgcn_s_sleep(1); \
    if ((++_sp & 255u) == 0u) { if (xb_ld(&(bar)[XB_TMO])) break; if (_sp > XB_SPIN_CAP) { atomicAdd(&(bar)[XB_TMO], 1u); break; } } } } while (0)
struct XcdBarrier { unsigned* bar; unsigned x; volatile LAS unsigned* st; };
DI XcdBarrier xcd_barrier_post(unsigned* bar, volatile LAS unsigned* st) {
    XcdBarrier b; b.bar = bar; b.x = xb_xcc_id(); b.st = st;
    if (threadIdx.x == 0) (void)xb_add(&bar[XB_XCNT(b.x)], 1u);
    return b;
}
DI void xcd_barrier_complete(unsigned* bar, unsigned x, unsigned& nloc, unsigned& nx) {
    const unsigned G = gridDim.x * gridDim.y * gridDim.z;
    unsigned sum, cnt, mine, sp = 0u;
    for (;;) {
        sum = 0u; cnt = 0u; mine = 0u;
#pragma unroll
        for (unsigned j = 0; j < 16; ++j) { const unsigned c = xb_ld(&bar[XB_XCNT(j)]); sum += c; cnt += (c > 0u) ? 1u : 0u; mine = (j == x) ? c : mine; }
        if (sum == G) break;
        __builtin_amdgcn_s_sleep(1);
        if ((++sp & 255u) == 0u) { if (xb_ld(&bar[XB_TMO])) break; if (sp > XB_SPIN_CAP) { atomicAdd(&bar[XB_TMO], 1u); break; } }
    }
    nloc = mine > 0u ? mine : 1u; nx = cnt > 0u ? cnt : 1u;
}
DI void xcd_barrier(const XcdBarrier& b) {
    asm volatile("s_waitcnt vmcnt(0)" ::: "memory");
    __syncthreads();
    if (threadIdx.x == 0) {
        unsigned* bar = b.bar;
        __builtin_amdgcn_s_waitcnt(0);
        unsigned nloc = b.st[0], nx = b.st[1];
        if (nloc == 0u) { xcd_barrier_complete(bar, b.x, nloc, nx); b.st[0] = nloc; b.st[1] = nx; }
        const unsigned old = xb_add(&bar[XB_XSUB(b.x)], 1u);
        const unsigned gen = old / nloc;
        if (old + 1u == (gen + 1u) * nloc) {
            __builtin_amdgcn_fence(__ATOMIC_RELEASE, "agent");
            asm volatile("s_waitcnt vmcnt(0)" ::: "memory");
            const unsigned og = xb_add(&bar[XB_TOP], 1u);
            const unsigned tg = og / nx;
            if (og + 1u == (tg + 1u) * nx) xb_add(&bar[XB_TOPGEN], 1u);
            else XB_SPIN(xb_ld(&bar[XB_TOPGEN]) == tg, bar);
            __builtin_amdgcn_fence(__ATOMIC_ACQUIRE, "agent");
            xb_add(&bar[XB_XGEN(b.x)], 1u);
            asm volatile("s_waitcnt vmcnt(0)" ::: "memory");
        } else {
            XB_SPIN(xb_ld(&bar[XB_XGEN(b.x)]) == gen, bar);
            __builtin_amdgcn_fence(__ATOMIC_ACQUIRE, "agent");
            asm volatile("s_waitcnt vmcnt(0)" ::: "memory");
        }
    }
    __syncthreads();
}

namespace pg8 {
#define PG8_LAS __attribute__((address_space(3)))
constexpr int BM = 256, BK = 64, HALF = 128, HTB = HALF * BK * 2, STAGE_BYTES = 8 * HTB, NXCD = 8, WGM = 8;
__host__ __device__ __forceinline__ int lds_byte(int r, int c) { const int st = (r >> 4) * 2 + (c >> 5), rr = r & 15, cc = c & 31, ob = rr * 64 + cc * 2; return st * 1024 + (ob ^ (((ob >> 9) & 1) << 5)); }
__host__ __device__ __forceinline__ void stage_rc(int b, int& R, int& C) { const int st = b / 1024, sb = b % 1024, swz = sb ^ (((sb >> 9) & 1) << 5); R = (st >> 1) * 16 + swz / 64; C = (st & 1) * 32 + (swz % 64) / 2; }
__host__ __device__ __forceinline__ int perm32(int rho) { const int n = rho >> 4, i = rho & 15; return 8 * (i >> 2) + 4 * n + (i & 3); }
struct Unit { int pm, pn; };
struct Gemm { const bf16_t* A; const bf16_t* Bt; int M, N, K; };
struct StaticOrder {
    int nM, nN, nwg, G, c;
    __host__ __device__ void init(int M, int N, int G_, int c_) { nM = M / BM; nN = N / BM; nwg = nM * nN; G = G_; c = c_; }
    __host__ __device__ bool next(int i, Unit& u) const {
        const long L = (long)i * G + c; if (L >= nwg) return false;
        int wgid = (int)L; { const int q = nwg / NXCD, r = nwg % NXCD, xcd = wgid % NXCD, off = wgid / NXCD; wgid = (xcd < r ? xcd * (q + 1) : r * (q + 1) + (xcd - r) * q) + off; }
        const int nig = WGM * nN, gid = wgid / nig, fm = gid * WGM, gsz = (nM - fm) < WGM ? (nM - fm) : WGM;
        u.pm = fm + ((wgid % nig) % gsz); u.pn = (wgid % nig) / gsz; return true;
    }
    __device__ __forceinline__ void a_ready(const Unit&) const {}
    __device__ __forceinline__ void done(const Unit&) const {}
};

template <class Epi, class Sched>
__device__ __forceinline__ void gemm_phase(PG8_LAS unsigned char* lds, const Gemm g, const Sched& S, const Epi& E) {
    const int tid = opq_tid(), wid = __builtin_amdgcn_readfirstlane(tid >> 6), lane = tid & 63, wr = wid >> 2, wc = wid & 3, fr = lane & 15, fq = lane >> 4;
    const int K = g.K, nt = K / BK;
    unsigned voffA[2], voffB[2];
#pragma unroll
    for (int i = 0; i < 2; ++i) { int R, C; stage_rc(tid * 16 + i * 8192, R, C); const int Rb = Epi::PERM ? ((R & ~31) + perm32(R & 31)) : R;
        voffA[i] = (unsigned)(R * K + C) * 2u; voffB[i] = (unsigned)(Rb * K + C) * 2u; }
    const size_t kstep = (size_t)(BK * 2);
    const size_t hstep = (size_t)HALF * K * 2;
    const size_t tstep = 2 * hstep;
    const unsigned ldsw = (unsigned)wid * 1024u;
    const int aoff = lds_byte(wr * 64 + fr, fq * 8), boff = lds_byte(wc * 32 + fr, fq * 8);
#define PG8_SA(b, h) (((b) * 2 + (h)) * HTB)
#define PG8_SB(b, h) ((4 + (b) * 2 + (h)) * HTB)
#define PG8_STAGE(bufoff, gbase, voff) do { _Pragma("unroll") for (int _i = 0; _i < 2; ++_i) \
        __builtin_amdgcn_global_load_lds((const unsigned*)((const char*)(gbase) + (voff)[_i]), (PG8_LAS unsigned*)(lds + (bufoff) + ldsw + _i * 8192), 16, 0, 0); } while (0)
#define PG8_LDA(dst, b, h) do { _Pragma("unroll") for (int m = 0; m < 4; ++m) _Pragma("unroll") for (int k = 0; k < 2; ++k) dst[m][k] = *(const PG8_LAS bf16x8*)(lds + PG8_SA(b, h) + aoff + m * 2048 + k * 1024); } while (0)
#define PG8_LDB(dst, b, h) do { _Pragma("unroll") for (int n = 0; n < 2; ++n) _Pragma("unroll") for (int k = 0; k < 2; ++k) dst[n][k] = *(const PG8_LAS bf16x8*)(lds + PG8_SB(b, h) + boff + n * 2048 + k * 1024); } while (0)
#define PG8_MMA(ai, bj, At, Bt) do { __builtin_amdgcn_s_setprio(1); _Pragma("unroll") for (int m = 0; m < 4; ++m) _Pragma("unroll") for (int n = 0; n < 2; ++n) _Pragma("unroll") for (int k = 0; k < 2; ++k) \
        acc[ai][bj][m][n] = __builtin_amdgcn_mfma_f32_16x16x32_bf16(Bt[n][k], At[m][k], acc[ai][bj][m][n], 0, 0, 0); __builtin_amdgcn_s_setprio(0); } while (0)
#define PG8_WAIT_V(n) asm volatile("s_waitcnt vmcnt(" #n ")" ::: "memory")
#define PG8_WAIT_L(n) asm volatile("s_waitcnt lgkmcnt(" #n ")" ::: "memory")
#define PG8_BAR __builtin_amdgcn_s_barrier()
#define PG8_SCHED __builtin_amdgcn_sched_barrier(0)
    Unit cur, nxt; int ui = 0;
    if (!S.next(0, cur)) return;
    f32x4 acc[2][2][4][2];
#pragma unroll
    for (int a = 0; a < 2; ++a)
#pragma unroll
        for (int b = 0; b < 2; ++b)
#pragma unroll
            for (int m = 0; m < 4; ++m)
#pragma unroll
                for (int n = 0; n < 2; ++n) acc[a][b][m][n] = (f32x4){0.f, 0.f, 0.f, 0.f};
    bf16x8 At[4][2], B0[2][2], B1[2][2];
    const char* cA = (const char*)g.A + (size_t)cur.pm * tstep; const char* cB = (const char*)g.Bt + (size_t)cur.pn * tstep;
    S.a_ready(cur);
    PG8_STAGE(PG8_SB(0, 0), cB, voffB); PG8_STAGE(PG8_SA(0, 0), cA, voffA); PG8_STAGE(PG8_SB(0, 1), cB + hstep, voffB); PG8_STAGE(PG8_SA(0, 1), cA + hstep, voffA);
    if (wr == 1) PG8_BAR;
    PG8_WAIT_V(4); PG8_BAR;
    PG8_STAGE(PG8_SB(1, 0), cB + kstep, voffB); PG8_STAGE(PG8_SA(1, 0), cA + kstep, voffA); PG8_STAGE(PG8_SB(1, 1), cB + hstep + kstep, voffB);
    PG8_WAIT_V(6); PG8_BAR;
    for (;;) {
        const bool has_next = S.next(ui + 1, nxt);
        const char* nA = has_next ? (const char*)g.A + (size_t)nxt.pm * tstep : cA; const char* nB = has_next ? (const char*)g.Bt + (size_t)nxt.pn * tstep : cB;
        for (int t = 0; t < nt; t += 2) {
            const bool last = (t == nt - 2);
            const char* a1 = cA + (size_t)(t + 1) * kstep;
            const char* a2 = last ? nA : cA + (size_t)(t + 2) * kstep; const char* b2 = last ? nB : cB + (size_t)(t + 2) * kstep;
            const char* a3 = a2 + kstep; const char* b3 = b2 + kstep;
            if (last && has_next) S.a_ready(nxt);
            PG8_LDB(B0, 0, 0); PG8_SCHED; PG8_LDA(At, 0, 0); PG8_STAGE(PG8_SA(1, 1), a1 + hstep, voffA);
            PG8_WAIT_L(8); PG8_BAR; PG8_WAIT_L(0); PG8_MMA(0, 0, At, B0); PG8_BAR; PG8_SCHED;
            PG8_LDB(B1, 0, 1); PG8_STAGE(PG8_SB(0, 0), b2, voffB);
            PG8_BAR; PG8_WAIT_L(0); PG8_MMA(0, 1, At, B1); PG8_BAR;
            PG8_LDA(At, 0, 1); PG8_STAGE(PG8_SA(0, 0), a2, voffA);
            PG8_BAR; PG8_WAIT_L(0); PG8_MMA(1, 0, At, B0); PG8_BAR; PG8_SCHED;
            PG8_STAGE(PG8_SB(0, 1), b2 + hstep, voffB);
            PG8_WAIT_V(6); PG8_BAR; PG8_MMA(1, 1, At, B1); PG8_BAR;
            PG8_LDB(B0, 1, 0); PG8_SCHED; PG8_LDA(At, 1, 0); PG8_STAGE(PG8_SA(0, 1), a2 + hstep, voffA);
            PG8_WAIT_L(8); PG8_BAR; PG8_WAIT_L(0); PG8_MMA(0, 0, At, B0); PG8_BAR; PG8_SCHED;
            PG8_LDB(B1, 1, 1); PG8_STAGE(PG8_SB(1, 0), b3, voffB);
            PG8_BAR; PG8_WAIT_L(0); PG8_MMA(0, 1, At, B1); PG8_BAR;
            PG8_LDA(At, 1, 1); PG8_STAGE(PG8_SA(1, 0), a3, voffA);
            PG8_BAR; PG8_WAIT_L(0); PG8_MMA(1, 0, At, B0); PG8_BAR; PG8_SCHED;
            PG8_STAGE(PG8_SB(1, 1), b3 + hstep, voffB);
            PG8_WAIT_V(6); PG8_BAR; PG8_MMA(1, 1, At, B1); PG8_BAR;
        }
        E(acc, cur, wr, wc, fr, fq); S.done(cur);
        if (!has_next) break;
#pragma unroll
        for (int a = 0; a < 2; ++a)
#pragma unroll
            for (int b = 0; b < 2; ++b)
#pragma unroll
                for (int m = 0; m < 4; ++m)
#pragma unroll
                    for (int n = 0; n < 2; ++n) acc[a][b][m][n] = (f32x4){0.f, 0.f, 0.f, 0.f};
        cur = nxt; cA = nA; cB = nB; ++ui;
    }
    PG8_WAIT_V(0);
    if (wr == 0) PG8_BAR;
    PG8_BAR;
#undef PG8_SA
#undef PG8_SB
#undef PG8_STAGE
#undef PG8_LDA
#undef PG8_LDB
#undef PG8_MMA
#undef PG8_WAIT_V
#undef PG8_WAIT_L
#undef PG8_BAR
#undef PG8_SCHED
}
}

typedef f32x4 AccT[2][2][4][2];
DI void store8(bf16_t* p, f32x4 a, f32x4 b) { u32x4 w = {cvt_pk_bf16(a[0], a[1]), cvt_pk_bf16(a[2], a[3]), cvt_pk_bf16(b[0], b[1]), cvt_pk_bf16(b[2], b[3])}; *(u32x4*)p = w; }
DI f32x4 silu4(f32x4 v) { f32x4 r; r[0] = silu_f(v[0]); r[1] = silu_f(v[1]); r[2] = silu_f(v[2]); r[3] = silu_f(v[3]); return r; }

struct EpiAttnIn {
    static constexpr bool PERM = true;
    bf16_t* q; bf16_t* sg; bf16_t* kb; bf16_t* vb;
    DI void operator()(const AccT& acc, const pg8::Unit& u, int wr, int wc, int fr, int fq) const {
        const int pn = u.pn, pm = u.pm, lrow0 = wr * 64 + fr, cl = wc * 32 + 8 * fq;
        if (pn < 8) {
            bf16_t* dst = (pn < 4 ? q : sg) + (pn & 3) * 256 + cl; const bool act = pn >= 4;
#pragma unroll
            for (int ai = 0; ai < 2; ++ai)
#pragma unroll
                for (int m = 0; m < 4; ++m) { const size_t row = (size_t)pm * 256 + lrow0 + ai * 128 + m * 16;
#pragma unroll
                    for (int bj = 0; bj < 2; ++bj) { f32x4 v0 = acc[ai][bj][m][0], v1 = acc[ai][bj][m][1]; if (act) { v0 = silu4(v0); v1 = silu4(v1); }
                        store8(dst + row * 1024 + bj * 128, v0, v1); } }
        } else {
            bf16_t* dst = (pn == 8 ? kb : vb) + cl;
            const int kvbase = pm < 128 ? (pm >> 4) * KVS + (pm & 15) * 256 : (pm - 128) * KVS + SEQ;
#pragma unroll
            for (int ai = 0; ai < 2; ++ai)
#pragma unroll
                for (int m = 0; m < 4; ++m) { const size_t row = (size_t)kvbase + lrow0 + ai * 128 + m * 16;
#pragma unroll
                    for (int bj = 0; bj < 2; ++bj) store8(dst + row * 256 + bj * 128, acc[ai][bj][m][0], acc[ai][bj][m][1]); }
        }
    }
};
struct EpiRetIn {
    static constexpr bool PERM = true;
    bf16_t* q; bf16_t* k; bf16_t* v; const h16x2* rope;
    DI void operator()(const AccT& acc, const pg8::Unit& u, int wr, int wc, int fr, int fq) const {
        const int pn = u.pn, pm = u.pm, lrow0 = wr * 64 + fr, cl = wc * 32 + 8 * fq;
        if (pn < 8) {
            bf16_t* dst = (pn < 4 ? q : k) + (pn & 3) * 256 + cl; const float scl = pn < 4 ? 1.f : 0.0625f;
            h16x8 cs[2][4][2];
#pragma unroll
            for (int ai = 0; ai < 2; ++ai)
#pragma unroll
                for (int m = 0; m < 4; ++m) { const int row = pm * 256 + lrow0 + ai * 128 + m * 16;
                    const int pos = pm < 128 ? CTXL + (row & (SEQ - 1)) : (row & (CTXL - 1));
                    const h16x8* rp = (const h16x8*)(rope + (size_t)pos * 128 + cl);
                    cs[ai][m][0] = rp[0]; cs[ai][m][1] = rp[1]; }
#pragma unroll
            for (int ai = 0; ai < 2; ++ai)
#pragma unroll
                for (int m = 0; m < 4; ++m) { const int row = pm * 256 + lrow0 + ai * 128 + m * 16;
                    f32x4 o1[2], o2[2];
#pragma unroll
                    for (int n = 0; n < 2; ++n) { const h16x8 c8 = cs[ai][m][n];
                        const f32x4 x1 = acc[ai][0][m][n], x2 = acc[ai][1][m][n];
#pragma unroll
                        for (int e = 0; e < 4; ++e) { const float c = (float)c8[2 * e], sn = (float)c8[2 * e + 1];
                            o1[n][e] = (x1[e] * c - x2[e] * sn) * scl; o2[n][e] = (x1[e] * sn + x2[e] * c) * scl; } }
                    store8(dst + (size_t)row * 1024, o1[0], o1[1]); store8(dst + (size_t)row * 1024 + 128, o2[0], o2[1]); }
        } else {
            bf16_t* dst = v + (pn - 8) * 256 + cl;
#pragma unroll
            for (int ai = 0; ai < 2; ++ai)
#pragma unroll
                for (int m = 0; m < 4; ++m) { const size_t row = (size_t)pm * 256 + lrow0 + ai * 128 + m * 16;
#pragma unroll
                    for (int bj = 0; bj < 2; ++bj) store8(dst + row * 2048 + bj * 128, acc[ai][bj][m][0], acc[ai][bj][m][1]); }
        }
    }
};
struct EpiGN {
    static constexpr bool PERM = true;
    bf16_t* o; const float* stats; const float* gn;
    DI void operator()(const AccT& acc, const pg8::Unit& u, int wr, int wc, int fr, int fq) const {
        const int col0 = u.pn * 256 + wc * 32 + 8 * fq, head = u.pn >> 1;
        f32x4 g0[2], g1[2];
#pragma unroll
        for (int bj = 0; bj < 2; ++bj) { g0[bj] = *(const f32x4*)(gn + col0 + bj * 128); g1[bj] = *(const f32x4*)(gn + col0 + bj * 128 + 4); }
#pragma unroll
        for (int ai = 0; ai < 2; ++ai) {
            float2 st[4]; u32x4 ov[4][2];
#pragma unroll
            for (int m = 0; m < 4; ++m) { const size_t row = (size_t)u.pm * 256 + wr * 64 + fr + ai * 128 + m * 16;
                st[m] = *(const float2*)(stats + (row * 4 + head) * 2);
#pragma unroll
                for (int bj = 0; bj < 2; ++bj) ov[m][bj] = *(const u32x4*)(o + row * 2048 + col0 + bj * 128); }
#pragma unroll
            for (int m = 0; m < 4; ++m) { const size_t row = (size_t)u.pm * 256 + wr * 64 + fr + ai * 128 + m * 16;
                const float mean = st[m].x * (1.f / 512.f), var = fmaxf(st[m].y * (1.f / 512.f) - mean * mean, 0.f), rstd = rsqrtf(var + 1e-5f);
#pragma unroll
                for (int bj = 0; bj < 2; ++bj) { bf16_t* op = o + row * 2048 + col0 + bj * 128; const u32x4 w = ov[m][bj];
                    const f32x4 s0 = silu4(acc[ai][bj][m][0]), s1 = silu4(acc[ai][bj][m][1]);
                    f32x4 y0, y1;
                    y0[0] = (bflo(w[0]) - mean) * rstd * g0[bj][0] * s0[0]; y0[1] = (bfhi(w[0]) - mean) * rstd * g0[bj][1] * s0[1];
                    y0[2] = (bflo(w[1]) - mean) * rstd * g0[bj][2] * s0[2]; y0[3] = (bfhi(w[1]) - mean) * rstd * g0[bj][3] * s0[3];
                    y1[0] = (bflo(w[2]) - mean) * rstd * g1[bj][0] * s1[0]; y1[1] = (bfhi(w[2]) - mean) * rstd * g1[bj][1] * s1[1];
                    y1[2] = (bflo(w[3]) - mean) * rstd * g1[bj][2] * s1[2]; y1[3] = (bfhi(w[3]) - mean) * rstd * g1[bj][3] * s1[3];
                    store8(op, y0, y1); } } }
    }
};
struct EpiPlain {
    static constexpr bool PERM = true;
    bf16_t* o; int ldc;
    DI void operator()(const AccT& acc, const pg8::Unit& u, int wr, int wc, int fr, int fq) const {
        bf16_t* dst = o + u.pn * 256 + wc * 32 + 8 * fq;
#pragma unroll
        for (int ai = 0; ai < 2; ++ai)
#pragma unroll
            for (int m = 0; m < 4; ++m) { const size_t row = (size_t)u.pm * 256 + wr * 64 + fr + ai * 128 + m * 16;
#pragma unroll
                for (int bj = 0; bj < 2; ++bj) store8(dst + row * ldc + bj * 128, acc[ai][bj][m][0], acc[ai][bj][m][1]); }
    }
};

namespace at {
constexpr int D = 128, NW = 8, QBLK = 32, KVBLK = 64;
constexpr float SCALE = 0.088388347648318440f;
constexpr float THR = 8.f;
constexpr int LDQ = 1024, LDK = 256;
constexpr size_t SHM_V = KVBLK * D * 2, SHM_K = KVBLK * D * 2, SHM_ATTN = 2 * SHM_V + 2 * SHM_K + NW * 64 * 4;
#define KSWZ(row, colB) ((row) * 256 + ((colB) ^ (((row) & 7) << 4)))
#define SBAR() __builtin_amdgcn_sched_barrier(0)
DI int crow(int r, int hi) { return (r & 3) + 8 * (r >> 2) + 4 * hi; }
DI unsigned cvtpk(float lo, float hi) { unsigned r; asm volatile("v_cvt_pk_bf16_f32 %0, %1, %2" : "=v"(r) : "v"(lo), "v"(hi)); return r; }
DI bf16x8 ld8(const bf16_t* p) { return *reinterpret_cast<const bf16x8*>(p); }

DI void partialSM(f32x16& p0, f32x16& p1, float& m_reg, float& mn, float& alpha) {
  constexpr float C = SCALE * 1.4426950408889634f;
  float pmax = p0[0]; for (int r = 1; r < 16; ++r) pmax = fmaxf(pmax, p0[r]); for (int r = 0; r < 16; ++r) pmax = fmaxf(pmax, p1[r]);
  { auto rr = __builtin_amdgcn_permlane32_swap(__float_as_uint(pmax), __float_as_uint(pmax), false, false);
    pmax = fmaxf(__uint_as_float(rr[0]), __uint_as_float(rr[1])); }
  if (__builtin_expect(__all(pmax - m_reg <= THR / SCALE), 1)) { mn = m_reg; alpha = 1.f; }
  else { mn = fmaxf(m_reg, pmax); alpha = __builtin_amdgcn_exp2f((m_reg - mn) * C); m_reg = mn; }
  float mnC = -mn * C;
  for (int r = 0; r < 16; ++r) p0[r] = fmaf(p0[r], C, mnC); for (int r = 0; r < 16; ++r) p1[r] = fmaf(p1[r], C, mnC);
  for (int r = 0; r < 16; ++r) p0[r] = __builtin_amdgcn_exp2f(p0[r]);
}
DI void finishSM(f32x16& p0, f32x16& p1, float alpha, float& l_reg, bf16x8& pa0, bf16x8& pa1, bf16x8& pa2, bf16x8& pa3) {
  for (int r = 0; r < 16; ++r) p1[r] = __builtin_amdgcn_exp2f(p1[r]);
  float ps = 0; for (int r = 0; r < 16; ++r) ps += p0[r]; for (int r = 0; r < 16; ++r) ps += p1[r];
  { auto rr = __builtin_amdgcn_permlane32_swap(__float_as_uint(ps), __float_as_uint(ps), false, false);
    ps = __uint_as_float(rr[0]) + __uint_as_float(rr[1]); }
  l_reg = l_reg * alpha + ps;
#define PK4(P, BASE, OUT) do { unsigned a0 = cvtpk(P[BASE + 0], P[BASE + 1]), a1 = cvtpk(P[BASE + 2], P[BASE + 3]);   \
    unsigned b0 = cvtpk(P[BASE + 4], P[BASE + 5]), b1 = cvtpk(P[BASE + 6], P[BASE + 7]);                              \
    auto r0 = __builtin_amdgcn_permlane32_swap(a0, b0, false, false); auto r1 = __builtin_amdgcn_permlane32_swap(a1, b1, false, false); \
    u32x4 w = {r0[0], r1[0], r0[1], r1[1]}; OUT = *reinterpret_cast<bf16x8*>(&w); } while (0)
  PK4(p0, 0, pa0); PK4(p0, 8, pa1); PK4(p1, 0, pa2); PK4(p1, 8, pa3);
#undef PK4
}
DI void qkt(f32x16& p0, f32x16& p1, const bf16_t* Ks, const bf16x8* qr, int r32, int hi) {
  p0 = f32x16{}; p1 = f32x16{};
  for (int d0 = 0; d0 < 8; ++d0) { int cb = (d0 * 16 + hi * 8) * 2;
    bf16x8 b0 = *reinterpret_cast<const bf16x8*>((const char*)Ks + KSWZ(r32, cb));
    bf16x8 b1 = *reinterpret_cast<const bf16x8*>((const char*)Ks + KSWZ(32 + r32, cb));
    p0 = __builtin_amdgcn_mfma_f32_32x32x16_bf16(b0, qr[d0], p0, 0, 0, 0);
    p1 = __builtin_amdgcn_mfma_f32_32x32x16_bf16(b1, qr[d0], p1, 0, 0, 0); }
}
DI int v_st(int k, int c) { const int kk = (k & ~0xC) | ((k & 4) << 1) | ((k & 8) >> 1); return ((kk >> 3) * 4 + (c >> 5)) * 512 + ((kk & 7) * 32 + (c & 31)) * 2; }
DI int v_rd_base(int lane) { return ((lane & 3) << 3) | (((lane >> 2) & 3) << 6) | (((lane >> 4) & 1) << 5) | (((lane >> 5) & 1) << 8); }
constexpr int v_rd_off(int d0, int ks, int half) { return d0 * 512 + ks * 4096 + half * 2048; }
template <int OFF> DI s16x4 tr_read(int vb) {
  s16x4 r; asm volatile("ds_read_b64_tr_b16 %0, %1 offset:%2" : "=&v"(r) : "v"(vb), "i"(OFF) : "memory"); return r;
}
template <int D0> DI void pv_one(f32x16& od, int vb, bf16x8 pa0, bf16x8 pa1, bf16x8 pa2, bf16x8 pa3) {
  const s16x4 l0 = tr_read<v_rd_off(D0, 0, 0)>(vb), h0 = tr_read<v_rd_off(D0, 0, 1)>(vb), l1 = tr_read<v_rd_off(D0, 1, 0)>(vb), h1 = tr_read<v_rd_off(D0, 1, 1)>(vb);
  const s16x4 l2 = tr_read<v_rd_off(D0, 2, 0)>(vb), h2 = tr_read<v_rd_off(D0, 2, 1)>(vb), l3 = tr_read<v_rd_off(D0, 3, 0)>(vb), h3 = tr_read<v_rd_off(D0, 3, 1)>(vb);
  asm volatile("s_waitcnt lgkmcnt(0)" ::: "memory"); SBAR();
#define PK(L, H) (bf16x8){L[0], L[1], L[2], L[3], H[0], H[1], H[2], H[3]}
  od = __builtin_amdgcn_mfma_f32_32x32x16_bf16(pa0, PK(l0, h0), od, 0, 0, 0);
  od = __builtin_amdgcn_mfma_f32_32x32x16_bf16(pa1, PK(l1, h1), od, 0, 0, 0);
  od = __builtin_amdgcn_mfma_f32_32x32x16_bf16(pa2, PK(l2, h2), od, 0, 0, 0);
  od = __builtin_amdgcn_mfma_f32_32x32x16_bf16(pa3, PK(l3, h3), od, 0, 0, 0);
#undef PK
}
DI void pv_d0(f32x16* o, int vb, bf16x8 pa0, bf16x8 pa1, bf16x8 pa2, bf16x8 pa3) {
  pv_one<0>(o[0], vb, pa0, pa1, pa2, pa3); pv_one<1>(o[1], vb, pa0, pa1, pa2, pa3); pv_one<2>(o[2], vb, pa0, pa1, pa2, pa3); pv_one<3>(o[3], vb, pa0, pa1, pa2, pa3);
}
DI void attn_dense_body(const bf16_t* __restrict__ Qb, const bf16_t* __restrict__ Kh, const bf16_t* __restrict__ Vh,
                        const bf16_t* __restrict__ Gb, bf16_t* __restrict__ Ob, int seq, char* lds,
                        const float* __restrict__ qsc, const float2* __restrict__ ropeA, int rope_t0) {
  const int tid = opq_tid(), wid = tid >> 6, lane = tid & 63, r32 = lane & 31, hi = lane >> 5;
  bf16_t* V_lds = (bf16_t*)lds; bf16_t* K_lds = (bf16_t*)(lds + 2 * SHM_V);
  float* ws = (float*)(lds + 2 * SHM_V + 2 * SHM_K) + wid * 64; float* li_l = ws; float* al_l = ws + 32;
  float m_reg = -1e30f, l_reg = 0; f32x16 o[4] = {}; bf16x8 qr[8];
  const bf16_t* Qw = Qb + (long)(wid * QBLK + r32) * LDQ + hi * 8;
#pragma unroll
  for (int d0 = 0; d0 < 8; ++d0) qr[d0] = ld8(Qw + d0 * 16);
  {
    float xf[8][8]; float ss = 0.f;
#pragma unroll
    for (int d0 = 0; d0 < 8; ++d0) { const u32x4 w = *reinterpret_cast<const u32x4*>(&qr[d0]);
#pragma unroll
      for (int i = 0; i < 4; ++i) { xf[d0][2 * i] = bflo(w[i]); xf[d0][2 * i + 1] = bfhi(w[i]); ss += xf[d0][2 * i] * xf[d0][2 * i] + xf[d0][2 * i + 1] * xf[d0][2 * i + 1]; } }
    { auto rr = __builtin_amdgcn_permlane32_swap(__float_as_uint(ss), __float_as_uint(ss), false, false); ss = __uint_as_float(rr[0]) + __uint_as_float(rr[1]); }
    const float rinv = rsqrtf(ss * (1.f / 128.f) + 1e-6f);
#pragma unroll
    for (int d0 = 0; d0 < 8; ++d0) { const f32x4 s0 = *(const f32x4*)(qsc + d0 * 16 + hi * 8), s1 = *(const f32x4*)(qsc + d0 * 16 + hi * 8 + 4);
#pragma unroll
      for (int e = 0; e < 4; ++e) { xf[d0][e] *= rinv * s0[e]; xf[d0][4 + e] *= rinv * s1[e]; } }
    if (rope_t0 >= 0) { const int t = rope_t0 + wid * QBLK + r32;
#pragma unroll
      for (int half = 0; half < 2; ++half) { const int pos = half ? (t & 63) : (t >> 6);
#pragma unroll
        for (int dp = 0; dp < 2; ++dp) { const f32x4* cp = (const f32x4*)(ropeA + pos * 32 + dp * 16 + hi * 8);
#pragma unroll
          for (int e2 = 0; e2 < 4; ++e2) { const f32x4 cs = cp[e2];
            const int da = half * 4 + dp, db = da + 2;
            float x1 = xf[da][2 * e2], x2 = xf[db][2 * e2]; xf[da][2 * e2] = x1 * cs[0] - x2 * cs[1]; xf[db][2 * e2] = x1 * cs[1] + x2 * cs[0];
            x1 = xf[da][2 * e2 + 1]; x2 = xf[db][2 * e2 + 1]; xf[da][2 * e2 + 1] = x1 * cs[2] - x2 * cs[3]; xf[db][2 * e2 + 1] = x1 * cs[3] + x2 * cs[2]; } } } }
#pragma unroll
    for (int d0 = 0; d0 < 8; ++d0) { u32x4 w = {cvtpk(xf[d0][0], xf[d0][1]), cvtpk(xf[d0][2], xf[d0][3]), cvtpk(xf[d0][4], xf[d0][5]), cvtpk(xf[d0][6], xf[d0][7])}; qr[d0] = *reinterpret_cast<bf16x8*>(&w); }
  }
  const int sr = tid >> 4, sc = (tid & 15) * 8, vst0 = v_st(sr, sc), vst1 = v_st(32 + sr, sc);
  const int vb0 = (int)(uintptr_t)V_lds + v_rd_base(lane);
  struct { bf16x8 vs0, vs1, ks0, ks1; } sr_[2];
#define SLOAD(i, k0) do { sr_[i].vs0 = ld8(&Vh[(long)((k0) + sr) * LDK + sc]); sr_[i].vs1 = ld8(&Vh[(long)((k0) + 32 + sr) * LDK + sc]); \
    sr_[i].ks0 = ld8(&Kh[(long)((k0) + sr) * LDK + sc]); sr_[i].ks1 = ld8(&Kh[(long)((k0) + 32 + sr) * LDK + sc]); } while (0)
#define SWRITE(b, i) do { *(bf16x8*)((char*)V_lds + (b) * SHM_V + vst0) = sr_[i].vs0;          \
    *(bf16x8*)((char*)V_lds + (b) * SHM_V + vst1) = sr_[i].vs1; int kc = sc * 2;               \
    *(bf16x8*)((char*)K_lds + (b) * SHM_K + KSWZ(sr, kc)) = sr_[i].ks0;                       \
    *(bf16x8*)((char*)K_lds + (b) * SHM_K + KSWZ(32 + sr, kc)) = sr_[i].ks1; } while (0)
#define SWAIT() asm volatile("s_waitcnt vmcnt(4)" ::: "memory")
#define RESC(a) do { if (__any((a) < 1.f)) { if (hi == 0) al_l[r32] = (a); asm volatile("s_waitcnt lgkmcnt(0)" ::: "memory"); \
    for (int d = 0; d < 4; ++d) for (int r = 0; r < 16; ++r) o[d][r] *= al_l[crow(r, hi)]; } } while (0)
  f32x16 pA0, pA1, pB0, pB1; float mnA, mnB, alA, alB; bf16x8 pa0, pa1, pa2, pa3; const int NT = seq / KVBLK;
  constexpr int SE = 0, SO = 1;
  SLOAD(SE, 0); asm volatile("s_waitcnt vmcnt(0)" ::: "memory"); SWRITE(0, SE); __syncthreads();
  qkt(pA0, pA1, K_lds, qr, r32, hi); partialSM(pA0, pA1, m_reg, mnA, alA);
  SLOAD(SO, KVBLK); if (2 < NT) SLOAD(SE, 2 * KVBLK);
  SWAIT(); SWRITE(1, SO); __syncthreads();
  for (int j = 1; j + 1 < NT; j += 2) {
    SBAR(); qkt(pB0, pB1, (bf16_t*)((char*)K_lds + SHM_K), qr, r32, hi);
    finishSM(pA0, pA1, alA, l_reg, pa0, pa1, pa2, pa3); SBAR();
    SLOAD(SO, (j + 2) * KVBLK); SBAR();
    pv_d0(o, vb0, pa0, pa1, pa2, pa3); partialSM(pB0, pB1, m_reg, mnB, alB);
    __syncthreads(); SWAIT(); SWRITE(0, SE);
    RESC(alB); __syncthreads();
    SBAR(); qkt(pA0, pA1, K_lds, qr, r32, hi);
    finishSM(pB0, pB1, alB, l_reg, pa0, pa1, pa2, pa3); SBAR();
    if (j + 3 < NT) SLOAD(SE, (j + 3) * KVBLK); SBAR();
    pv_d0(o, vb0 + (int)SHM_V, pa0, pa1, pa2, pa3); partialSM(pA0, pA1, m_reg, mnA, alA);
    __syncthreads(); SWAIT(); SWRITE(1, SO);
    RESC(alA); __syncthreads();
  }
  SBAR(); qkt(pB0, pB1, (bf16_t*)((char*)K_lds + SHM_K), qr, r32, hi);
  finishSM(pA0, pA1, alA, l_reg, pa0, pa1, pa2, pa3); SBAR();
  pv_d0(o, vb0, pa0, pa1, pa2, pa3); partialSM(pB0, pB1, m_reg, mnB, alB);
  __syncthreads(); RESC(alB);
  finishSM(pB0, pB1, alB, l_reg, pa0, pa1, pa2, pa3); SBAR();
  pv_d0(o, vb0 + (int)SHM_V, pa0, pa1, pa2, pa3);
  if (hi == 0) li_l[r32] = l_reg; asm volatile("s_waitcnt lgkmcnt(0)" ::: "memory");
  float rli[16];
#pragma unroll
  for (int r = 0; r < 16; ++r) rli[r] = __builtin_amdgcn_rcpf(li_l[crow(r, hi)]);
  u32x4 gv[8];
#pragma unroll
  for (int it = 0; it < 8; ++it) gv[it] = *(const u32x4*)(Gb + (long)((tid >> 4) + 32 * it) * LDQ + (tid & 15) * 8);
  __syncthreads();
  bf16_t* stg = (bf16_t*)lds;
#pragma unroll
  for (int r = 0; r < 16; ++r) { bf16_t* sp = stg + (wid * QBLK + crow(r, hi)) * 136 + r32;
    sp[0] = f2bf(o[0][r] * rli[r]); sp[32] = f2bf(o[1][r] * rli[r]); sp[64] = f2bf(o[2][r] * rli[r]); sp[96] = f2bf(o[3][r] * rli[r]); }
  __syncthreads();
#pragma unroll
  for (int it = 0; it < 8; ++it) { const int row = (tid >> 4) + 32 * it, c8 = (tid & 15) * 8;
    const u32x4 ov = *(const u32x4*)(stg + row * 136 + c8);
    f32x4 y0, y1;
    y0[0] = bflo(ov[0]) * bflo(gv[it][0]); y0[1] = bfhi(ov[0]) * bfhi(gv[it][0]); y0[2] = bflo(ov[1]) * bflo(gv[it][1]); y0[3] = bfhi(ov[1]) * bfhi(gv[it][1]);
    y1[0] = bflo(ov[2]) * bflo(gv[it][2]); y1[1] = bfhi(ov[2]) * bfhi(gv[it][2]); y1[2] = bflo(ov[3]) * bflo(gv[it][3]); y1[3] = bfhi(ov[3]) * bfhi(gv[it][3]);
    store8(Ob + (long)row * LDQ + c8, y0, y1); }
#undef SLOAD
#undef SWRITE
#undef SWAIT
#undef RESC
  __syncthreads();
}
}

DI void mod_phase(const Args& a, float* ldsf) {
    const int tid = opq_tid();
    float* modv = (float*)(a.ws + OFF_MOD);
    if ((int)blockIdx.x >= 192) return;
    const float* c = a.in[1]; const float* cc = a.in[3];
    for (int i = tid; i < 9 * 1024; i += NTHREADS) { const int bb = i >> 10, k = i & 1023; const float v = bb < 8 ? c[bb * 1024 + k] : cc[k]; ldsf[i] = v / (1.f + expf(-v)); }
    __syncthreads();
    float* red = ldsf + 9 * 1024;
    for (int item = blockIdx.x; item < 192; item += gridDim.x) {
        const int l = item / 48, cgp = item % 48, cj = tid & 63, ks = tid >> 6, col = cgp * 64 + cj;
        float acc[9];
#pragma unroll
        for (int bb = 0; bb < 9; ++bb) acc[bb] = 0.f;
        const float* W = a.in[4] + (size_t)l * 1024 * 3072 + col;
        for (int k0 = ks * 128; k0 < ks * 128 + 128; k0 += 16) {
            float w[16];
#pragma unroll
            for (int u = 0; u < 16; ++u) w[u] = W[(size_t)(k0 + u) * 3072];
#pragma unroll
            for (int u = 0; u < 16; ++u) {
#pragma unroll
                for (int bb = 0; bb < 9; ++bb) acc[bb] = fmaf(ldsf[bb * 1024 + k0 + u], w[u], acc[bb]); } }
#pragma unroll
        for (int bb = 0; bb < 9; ++bb) red[(ks * 9 + bb) * 64 + cj] = acc[bb];
        __syncthreads();
        for (int i = tid; i < 9 * 64; i += NTHREADS) { const int bb = i >> 6, cj2 = i & 63; float s = 0.f;
#pragma unroll
            for (int k2 = 0; k2 < 8; ++k2) s += red[(k2 * 9 + bb) * 64 + cj2];
            const int col2 = cgp * 64 + cj2; modv[(size_t)(l * 9 + bb) * 3072 + col2] = s + a.in[5][l * 3072 + col2]; }
        __syncthreads();
    }
}
DI float2 cs_f64(double ang) {
    const double kq = rint(ang * 0.63661977236758134308);
    double r = fma(-kq, 1.57079632679489655800e+00, ang); r = fma(-kq, 6.12323399573676603587e-17, r);
    const double r2 = r * r;
    double sn = r * (1.0 + r2 * (-1.0 / 6 + r2 * (1.0 / 120 + r2 * (-1.0 / 5040 + r2 * (1.0 / 362880 + r2 * (-1.0 / 39916800 + r2 * (1.0 / 6227020800.0)))))));
    double cn = 1.0 + r2 * (-0.5 + r2 * (1.0 / 24 + r2 * (-1.0 / 720 + r2 * (1.0 / 40320 + r2 * (-1.0 / 3628800 + r2 * (1.0 / 479001600 + r2 * (-1.0 / 87178291200.0)))))));
    const int q = ((int)kq) & 3;
    double cc = (q == 0) ? cn : (q == 1) ? -sn : (q == 2) ? -cn : sn;
    double ss = (q == 0) ? sn : (q == 1) ? cn : (q == 2) ? -sn : -cn;
    return make_float2((float)cc, (float)ss);
}
DI void rope_phase(const Args& a) {
    h16x2* rr = (h16x2*)(a.ws + OFF_ROPER); float2* ra = (float2*)(a.ws + OFF_ROPEA);
    const int gt = blockIdx.x * NTHREADS + opq_tid(), gs = gridDim.x * NTHREADS;
    for (int i = gt; i < KVS * 128 + 64 * 32; i += gs) {
        if (i < KVS * 128) { const int pos = i >> 7, f = i & 127; const double fr = exp(-(double)f * (9.21034037197618273607 / 128.0)); const float2 v = cs_f64((double)pos * fr); h16x2 hv = {(_Float16)v.x, (_Float16)v.y}; rr[i] = hv; }
        else { const int j = i - KVS * 128, pos = j >> 5, f = j & 31; const double fr = exp(-(double)f * (9.21034037197618273607 / 32.0)); ra[j] = cs_f64((double)pos * fr); }
    }
}
DI void convert_wt(const float* __restrict__ W, bf16_t* __restrict__ Wt, int K, int N, float* tl) {
    const int tid = opq_tid(), ntn = N / 64, ntiles = (K / 64) * ntn;
    for (int tile = blockIdx.x; tile < ntiles; tile += gridDim.x) {
        const int k0 = (tile / ntn) * 64, n0 = (tile % ntn) * 64, tj = tid & 63, ti = tid >> 6;
#pragma unroll
        for (int ii = 0; ii < 8; ++ii) { const int k = ti * 8 + ii; tl[k * 65 + tj] = W[(size_t)(k0 + k) * N + n0 + tj]; }
        __syncthreads();
        const int n = tid >> 3, ks = (tid & 7) * 8;
        u32x4 w;
        w[0] = cvt_pk_bf16(tl[(ks + 0) * 65 + n], tl[(ks + 1) * 65 + n]); w[1] = cvt_pk_bf16(tl[(ks + 2) * 65 + n], tl[(ks + 3) * 65 + n]);
        w[2] = cvt_pk_bf16(tl[(ks + 4) * 65 + n], tl[(ks + 5) * 65 + n]); w[3] = cvt_pk_bf16(tl[(ks + 6) * 65 + n], tl[(ks + 7) * 65 + n]);
        *(u32x4*)(Wt + (size_t)(n0 + n) * K + k0 + ks) = w;
        __syncthreads();
    }
}
DI void convert_layer_weights(const Args& a, int l, float* tl) {
    bf16_t* wt = (bf16_t*)(a.ws + OFF_WT); const int j = l >> 1;
    if ((l & 1) == 0) { convert_wt(a.in[8] + (size_t)j * 1024 * ATT_IN, wt, 1024, ATT_IN, tl); convert_wt(a.in[9] + (size_t)j * 1024 * 1024, wt + (size_t)ATT_IN * 1024, 1024, 1024, tl); }
    else { convert_wt(a.in[12] + (size_t)j * 1024 * RET_IN, wt, 1024, RET_IN, tl); convert_wt(a.in[13] + (size_t)j * 2048 * 1024, wt + (size_t)RET_IN * 1024, 2048, 1024, tl); }
}
DI void modulate_phase(const Args& a) {
    const float* modv = (const float*)(a.ws + OFF_MOD); bf16_t* h = (bf16_t*)(a.ws + OFF_H);
    const size_t gt = (size_t)blockIdx.x * NTHREADS + opq_tid(), gs = (size_t)gridDim.x * NTHREADS;
    for (size_t i = gt; i < (size_t)TT * 128; i += gs) {
        const int row = (int)(i >> 7), c8 = (int)(i & 127) * 8;
        const float* xr = row < TL ? a.in[0] + (size_t)row * 1024 : a.in[2] + (size_t)(row - TL) * 1024;
        const int bb = row < TL ? (row >> 12) : 8;
        const float* mv = modv + (size_t)bb * 3072;
        const f32x4 x0 = *(const f32x4*)(xr + c8), x1 = *(const f32x4*)(xr + c8 + 4);
        const f32x4 sh0 = *(const f32x4*)(mv + c8), sh1 = *(const f32x4*)(mv + c8 + 4), sc0 = *(const f32x4*)(mv + 1024 + c8), sc1 = *(const f32x4*)(mv + 1024 + c8 + 4);
        store8(h + (size_t)row * 1024 + c8, x0 * (sc0 + 1.f) + sh0, x1 * (sc1 + 1.f) + sh1);
    }
}
template <int NR>
DI void ln_rows(const Args& a, int l, int row0, int lane, const f32x4 (&lgv)[4], const f32x4 (&lbv)[4], const f32x4 (&gate)[4], const f32x4 (&sh)[4], const f32x4 (&sc1)[4]) {
    bf16_t* h = (bf16_t*)(a.ws + OFF_H); float* zc = (float*)(a.ws + OFF_CTXR); const bf16_t* y = (const bf16_t*)(a.ws + OFF_R1);
    const float* xlat = l == 0 ? a.in[0] : a.out; const float* xctx = l == 0 ? a.in[2] : zc;
    f32x4 v[NR][4]; float s[NR];
#pragma unroll
    for (int k = 0; k < NR; ++k) { const int row = row0 + k; s[k] = 0.f;
        const float* xr = row < TL ? xlat + (size_t)row * 1024 : xctx + (size_t)(row - TL) * 1024;
#pragma unroll
        for (int i = 0; i < 4; ++i) { const int col = 4 * lane + 256 * i;
            const f32x4 xv = *(const f32x4*)(xr + col); const u32x2 yw = *(const u32x2*)(y + (size_t)row * 1024 + col);
            f32x4 yv; yv[0] = bflo(yw[0]); yv[1] = bfhi(yw[0]); yv[2] = bflo(yw[1]); yv[3] = bfhi(yw[1]);
            v[k][i] = xv * ALPHA + gate[i] * yv; s[k] += v[k][i][0] + v[k][i][1] + v[k][i][2] + v[k][i][3]; } }
    float mean[NR], rstd[NR];
#pragma unroll
    for (int k = 0; k < NR; ++k) mean[k] = wave_sum(s[k]) * (1.f / 1024.f);
#pragma unroll
    for (int k = 0; k < NR; ++k) { float q = 0.f;
#pragma unroll
        for (int i = 0; i < 4; ++i) { v[k][i] = v[k][i] - mean[k]; q += v[k][i][0] * v[k][i][0] + v[k][i][1] * v[k][i][1] + v[k][i][2] * v[k][i][2] + v[k][i][3] * v[k][i][3]; }
        rstd[k] = rsqrtf(wave_sum(q) * (1.f / 1024.f) + 1e-5f); }
#pragma unroll
    for (int k = 0; k < NR; ++k) { const int row = row0 + k;
        float* zr = row < TL ? a.out + (size_t)row * 1024 : zc + (size_t)(row - TL) * 1024;
#pragma unroll
        for (int i = 0; i < 4; ++i) { const int col = 4 * lane + 256 * i;
            const f32x4 yo = v[k][i] * rstd[k] * lgv[i] + lbv[i];
            *(f32x4*)(zr + col) = yo;
            if (l < 3) { const f32x4 hv = yo * sc1[i] + sh[i]; u32x2 w = {cvt_pk_bf16(hv[0], hv[1]), cvt_pk_bf16(hv[2], hv[3])}; *(u32x2*)(h + (size_t)row * 1024 + col) = w; } } }
}
DI void ln_phase(const Args& a, int l) {
    const float* lg = a.in[6] + l * 1024; const float* lb = a.in[7] + l * 1024;
    const float* modl = (const float*)(a.ws + OFF_MOD) + (size_t)l * 9 * 3072;
    const float* modn = modl + 9 * 3072;
    const int tid_ = opq_tid(), lane = tid_ & 63, wid = tid_ >> 6;
    f32x4 lgv[4], lbv[4], gate[4], sh[4], sc1[4];
#pragma unroll
    for (int i = 0; i < 4; ++i) { const int col = 4 * lane + 256 * i; lgv[i] = *(const f32x4*)(lg + col); lbv[i] = *(const f32x4*)(lb + col); }
    for (int gw = blockIdx.x * 8 + wid; gw < TL / 16; gw += gridDim.x * 8) {
        const int bb = gw >> 8;
#pragma unroll
        for (int i = 0; i < 4; ++i) { const int col = 4 * lane + 256 * i; gate[i] = *(const f32x4*)(modl + bb * 3072 + 2048 + col);
            sh[i] = *(const f32x4*)(modn + bb * 3072 + col); sc1[i] = *(const f32x4*)(modn + bb * 3072 + 1024 + col) + 1.f; }
#pragma unroll 1
        for (int r0 = 0; r0 < 15; r0 += 3) ln_rows<3>(a, l, gw * 16 + r0, lane, lgv, lbv, gate, sh, sc1);
        ln_rows<1>(a, l, gw * 16 + 15, lane, lgv, lbv, gate, sh, sc1);
    }
    if (l < 3) {
#pragma unroll
        for (int i = 0; i < 4; ++i) { const int col = 4 * lane + 256 * i; gate[i] = *(const f32x4*)(modl + 8 * 3072 + 2048 + col);
            sh[i] = *(const f32x4*)(modn + 8 * 3072 + col); sc1[i] = *(const f32x4*)(modn + 8 * 3072 + 1024 + col) + 1.f; }
        for (int gw = blockIdx.x * 8 + wid; gw < TC; gw += gridDim.x * 8) ln_rows<1>(a, l, TL + gw, lane, lgv, lbv, gate, sh, sc1);
    }
}
DI void attn_normrope_phase(const Args& a, int j) {
    bf16_t* kb = (bf16_t*)(a.ws + OFF_R3);
    const float2* ra = (const float2*)(a.ws + OFF_ROPEA);
    const float* ksc = a.in[11] + j * 128;
    const int tid_ = opq_tid(), lane = tid_ & 63, wid = tid_ >> 6, half = lane >> 5, i = lane & 31, e1 = half * 64 + i, e2 = e1 + 32;
    const float ks1 = ksc[e1], ks2 = ksc[e2];
    const int stride = gridDim.x * 8;
    constexpr int NRK = 4;
    for (int row0 = blockIdx.x * 8 + wid; row0 < TT; row0 += NRK * stride) {
        float x1[NRK][2], x2[NRK][2], cs[NRK], sn[NRK]; bf16_t* kp[NRK];
#pragma unroll
        for (int k = 0; k < NRK; ++k) { const int row = row0 + k * stride < TT ? row0 + k * stride : row0;
            const bool lat = row < TL; const int t = row & (SEQ - 1);
            cs[k] = 1.f; sn[k] = 0.f;
            if (lat) { const int pos = half ? (t & 63) : (t >> 6); const float2 v = ra[pos * 32 + i]; cs[k] = v.x; sn[k] = v.y; }
            const size_t kr = lat ? (size_t)(row >> 12) * KVS + t : (size_t)((row - TL) >> 8) * KVS + SEQ + (row & (CTXL - 1));
            kp[k] = kb + kr * 256;
#pragma unroll
            for (int hk = 0; hk < 2; ++hk) { x1[k][hk] = bf2f(kp[k][hk * 128 + e1]); x2[k][hk] = bf2f(kp[k][hk * 128 + e2]); } }
#pragma unroll
        for (int k = 0; k < NRK; ++k) { if (row0 + k * stride < TT) {
#pragma unroll
            for (int hh = 0; hh < 2; ++hh) {
                const float ss = wave_sum(x1[k][hh] * x1[k][hh] + x2[k][hh] * x2[k][hh]);
                const float rinv = rsqrtf(ss * (1.f / 128.f) + 1e-6f);
                const float y1 = x1[k][hh] * rinv * ks1, y2 = x2[k][hh] * rinv * ks2;
                kp[k][hh * 128 + e1] = f2bf(y1 * cs[k] - y2 * sn[k]); kp[k][hh * 128 + e2] = f2bf(y1 * sn[k] + y2 * cs[k]);
            } } }
    }
}
DI void attn_phase(const Args& a, int j, char* lds) {
    const bf16_t* q = (const bf16_t*)(a.ws + OFF_R1); const bf16_t* sg = (const bf16_t*)(a.ws + OFF_R2);
    const bf16_t* kb = (const bf16_t*)(a.ws + OFF_R3); const bf16_t* vb = kb + (size_t)NB * KVS * 256;
    bf16_t* ao = (bf16_t*)(a.ws + OFF_R4);
    const int c = blockIdx.x, G = gridDim.x;
    for (int u = c; u < 1024 + 64; u += G) {
        int b, h, row0, seq; size_t kvoff;
        if (u < 1024) {
            int pair, idx;
            if (G == 256) { const int rnd = u >> 8, cc = u & 255, xcd = cc & 7, slot = cc >> 3; pair = rnd * 4 + (xcd >> 1); idx = (xcd & 1) * 32 + slot; }
            else { pair = u >> 6; idx = u & 63; }
            b = pair >> 1; const int kvh = pair & 1; h = kvh * 4 + (idx >> 4); const int qb = idx & 15;
            row0 = b * SEQ + qb * 256; seq = KVS; kvoff = (size_t)b * KVS * 256 + kvh * 128;
        } else {
            const int v = u - 1024; b = v >> 3; h = v & 7; row0 = TL + b * CTXL; seq = CTXL; kvoff = ((size_t)b * KVS + SEQ) * 256 + (h >> 2) * 128;
        }
        const size_t qoff = (size_t)row0 * 1024 + h * 128;
        at::attn_dense_body(q + qoff, kb + kvoff, vb + kvoff, sg + qoff, ao + qoff, seq, lds, a.in[10] + j * 128, (const float2*)(a.ws + OFF_ROPEA), u < 1024 ? (row0 & (SEQ - 1)) : -1);
    }
}

namespace rt {
constexpr int C = 64;
constexpr int QRS = 528, KRS = 544, VRS = 160, PRS = 144;
constexpr int Q_OFF = 0, K_OFF = Q_OFF + 64 * QRS, V_OFF = K_OFF + 64 * KRS, P_OFF = V_OFF + 64 * VRS, X_OFF = P_OFF + 64 * PRS, S_OFF = X_OFF + 8 * 2048, SRS = 68 * 4, LDS_END = S_OFF + 64 * SRS;
static_assert(LDS_END <= LDS_MAIN && QRS == 528, "scan LDS");
DI int prow(int k) { return (k & ~12) | ((k & 4) << 1) | ((k & 8) >> 1); }
template <int OFF> DI s16x4 tr_rd(unsigned addr) { s16x4 r; asm volatile("ds_read_b64_tr_b16 %0, %1 offset:%2" : "=&v"(r) : "v"(addr), "i"(OFF) : "memory"); return r; }
DI bf16x8 cat(s16x4 l, s16x4 h) { return (bf16x8){l[0], l[1], l[2], l[3], h[0], h[1], h[2], h[3]}; }
template <int OFF> DI s16x4 rd64(unsigned addr) { s16x4 r; asm volatile("ds_read_b64 %0, %1 offset:%2" : "=&v"(r) : "v"(addr), "i"(OFF) : "memory"); return r; }
template <int S> DI void qs_load(bf16x8 (&d)[4], unsigned qb) {
    const s16x4 l0 = rd64<0 * 16 * 528 + S * 64>(qb), h0 = rd64<0 * 16 * 528 + S * 64 + 32>(qb), l1 = rd64<1 * 16 * 528 + S * 64>(qb), h1 = rd64<1 * 16 * 528 + S * 64 + 32>(qb);
    const s16x4 l2 = rd64<2 * 16 * 528 + S * 64>(qb), h2 = rd64<2 * 16 * 528 + S * 64 + 32>(qb), l3 = rd64<3 * 16 * 528 + S * 64>(qb), h3 = rd64<3 * 16 * 528 + S * 64 + 32>(qb);
    d[0] = cat(l0, h0); d[1] = cat(l1, h1); d[2] = cat(l2, h2); d[3] = cat(l3, h3);
}
#define MFMA16(a, b, c) __builtin_amdgcn_mfma_f32_16x16x32_bf16((a), (b), (c), 0, 0, 0)
#define RT_CB() do { asm volatile("" ::: "memory"); __builtin_amdgcn_sched_barrier(0); } while (0)
#define RT_LGKM(n) do { asm volatile("s_waitcnt lgkmcnt(" #n ")" ::: "memory"); __builtin_amdgcn_sched_barrier(0); } while (0)
template <int FWD> DI int chunk_row(int step, int b) {
    if (FWD) return step < 4 ? TL + b * CTXL + 64 * step : b * SEQ + 64 * (step - 4);
    return step < 4 ? TL + b * CTXL + 64 * (3 - step) : b * SEQ + 64 * (67 - step);
}
struct KT8 { s16x4 a0, a1, a2, a3, b0, b1, b2, b3; };
template <int T0> DI void kt_load(KT8& k, unsigned kb) {
    k.a0 = tr_rd<T0 * 32>(kb); k.a1 = tr_rd<T0 * 32 + 8 * KRS>(kb); k.a2 = tr_rd<T0 * 32 + 32 * KRS>(kb); k.a3 = tr_rd<T0 * 32 + 40 * KRS>(kb);
    k.b0 = tr_rd<T0 * 32 + 32>(kb); k.b1 = tr_rd<T0 * 32 + 32 + 8 * KRS>(kb); k.b2 = tr_rd<T0 * 32 + 32 + 32 * KRS>(kb); k.b3 = tr_rd<T0 * 32 + 32 + 40 * KRS>(kb);
}
DI void kt_mma(f32x4& sa, f32x4& sb, const KT8& k, bf16x8 vz0, bf16x8 vz1) {
    sa = MFMA16(cat(k.a0, k.a1), vz0, sa); sa = MFMA16(cat(k.a2, k.a3), vz1, sa);
    sb = MFMA16(cat(k.b0, k.b1), vz0, sb); sb = MFMA16(cat(k.b2, k.b3), vz1, sb);
}
}

namespace rt {
constexpr int V2RS = 288, S2RS = 132;
constexpr int V2_OFF = K_OFF + 64 * KRS, P2_OFF = V2_OFF + 64 * V2RS, S2_OFF = P2_OFF + 64 * PRS, LDS2_END = S2_OFF + 64 * S2RS * 4;
static_assert(LDS2_END <= LDS_MAIN, "scan2 LDS");
template <int FWD, class BarrierFn>
DI void scan2_dir(const bf16_t* __restrict__ Qg, const bf16_t* __restrict__ Kg, bf16_t* Vg, bf16_t* Tg, bf16_t* TCB, float* stats, int b, int h, int sl, float lg, char* lds, const BarrierFn& gbar) {
    const int tid = opq_tid(), wid = __builtin_amdgcn_readfirstlane(tid >> 6), lane = tid & 63, c = lane & 15, g = lane >> 4;
    const unsigned lb = (unsigned)(uintptr_t)lds;
    const int kt = wid >> 1, qt0 = 2 * (wid & 1);
    const size_t qkcol = (size_t)h * 256, vcol = (size_t)h * 512 + sl * 128;
    const int trrow = 16 * (g >> 1) + 4 * (g & 1) + (c >> 2);
    const unsigned kb_tr = lb + K_OFF + trrow * KRS + (4 * (c & 3)) * 2;
    const unsigned vb_tr = lb + V2_OFF + trrow * V2RS + (16 * wid + 4 * (c & 3)) * 2;
    const char* ks_rd = lds + K_OFF + (16 * kt + prow(c)) * KRS + 16 * g;
    const char* q0_rd = lds + Q_OFF + (16 * qt0 + c) * QRS + 16 * g;
    const unsigned qs_b = lb + Q_OFF + c * QRS + (4 * g) * 2;
    const char* p_rd = lds + P2_OFF + c * PRS + (8 * g) * 2;
    const float lg2 = lg * 1.4426950408889634f;
    const float gC = exp2f(lg2 * 64.f);
    float wm[4], zt0[8], zt1[8];
#pragma unroll
    for (int jj = 0; jj < 4; ++jj) { const int m = 16 * kt + 4 * g + jj; wm[jj] = exp2f(-lg2 * (float)(FWD ? m + 1 : 64 - m)); }
#pragma unroll
    for (int jj = 0; jj < 8; ++jj) { const int m = 8 * g + jj; zt0[jj] = exp2f(lg2 * (float)(64 - (FWD ? m + 1 : 64 - m))); zt1[jj] = exp2f(lg2 * (float)(64 - (FWD ? m + 33 : 32 - m))); }
    const int srow = tid >> 4, scp = tid & 15;
    const float xi0 = exp2f(lg2 * (float)(FWD ? srow + 1 : 64 - srow)), xi1 = exp2f(lg2 * (float)(FWD ? srow + 33 : 32 - srow));
    f32x4 st[16];
#pragma unroll
    for (int t = 0; t < 16; ++t) st[t] = (f32x4){0.f, 0.f, 0.f, 0.f};
    bf16x8 pq[4], pk[4], pv[2];
    float* stg_w = (float*)(lds + S2_OFF) + (4 * g) * S2RS + 16 * wid + c;
    const float* stg_r = (const float*)(lds + S2_OFF) + srow * S2RS + scp * 8;
#define R2_LOAD(rb) do { _Pragma("unroll") for (int i_ = 0; i_ < 4; ++i_) { const int p_ = tid + 512 * i_, r_ = p_ >> 5, cp_ = p_ & 31; \
        pq[i_] = *(const bf16x8*)(Qg + (size_t)((rb) + r_) * 1024 + qkcol + cp_ * 8); pk[i_] = *(const bf16x8*)(Kg + (size_t)((rb) + r_) * 1024 + qkcol + cp_ * 8); } \
        pv[0] = *(const bf16x8*)(Vg + (size_t)((rb) + srow) * 2048 + vcol + scp * 8); pv[1] = *(const bf16x8*)(Vg + (size_t)((rb) + srow + 32) * 2048 + vcol + scp * 8); } while (0)
#define R2_WRITE() do { _Pragma("unroll") for (int i_ = 0; i_ < 4; ++i_) { const int p_ = tid + 512 * i_, r_ = p_ >> 5, cp_ = p_ & 31; \
        *(bf16x8*)(lds + Q_OFF + r_ * QRS + cp_ * 16) = pq[i_]; *(bf16x8*)(lds + K_OFF + prow(r_) * KRS + cp_ * 16) = pk[i_]; } \
        *(bf16x8*)(lds + V2_OFF + prow(srow) * V2RS + scp * 16) = pv[0]; *(bf16x8*)(lds + V2_OFF + prow(srow + 32) * V2RS + scp * 16) = pv[1]; } while (0)
    R2_LOAD(chunk_row<FWD>(0, b)); R2_WRITE(); __syncthreads();
    for (int step = 0; step < 68; ++step) {
        if (step == 36) gbar();
        const int rb = chunk_row<FWD>(step, b);
        const bool fin = step >= 36;
        if (step + 1 < 68) { const int rbn = chunk_row<FWD>(step + 1, b); R2_LOAD(rbn); }
        bf16x8 tv0 = {}, tv1 = {};
        if (fin) { tv0 = *(const bf16x8*)(Tg + (size_t)(rb + srow) * 2048 + vcol + scp * 8); tv1 = *(const bf16x8*)(Tg + (size_t)(rb + srow + 32) * 2048 + vcol + scp * 8); }
        {
            f32x4 s0 = {0.f, 0.f, 0.f, 0.f}, s1 = {0.f, 0.f, 0.f, 0.f};
            bf16x8 ak[2], aq0[2], aq1[2], bk[2], bq0[2], bq1[2];
#define ST_LOAD(K_, Q0_, Q1_, S_) do { _Pragma("unroll") for (int i_ = 0; i_ < 2; ++i_) { K_[i_] = *(const bf16x8*)(ks_rd + 64 * ((S_) + i_)); \
                Q0_[i_] = *(const bf16x8*)(q0_rd + 64 * ((S_) + i_)); Q1_[i_] = *(const bf16x8*)(q0_rd + 16 * QRS + 64 * ((S_) + i_)); } RT_CB(); } while (0)
#define ST_MMA(K_, Q0_, Q1_) do { _Pragma("unroll") for (int i_ = 0; i_ < 2; ++i_) { s0 = MFMA16(K_[i_], Q0_[i_], s0); s1 = MFMA16(K_[i_], Q1_[i_], s1); } RT_CB(); } while (0)
            ST_LOAD(ak, aq0, aq1, 0); ST_LOAD(bk, bq0, bq1, 2);
            ST_MMA(ak, aq0, aq1); ST_LOAD(ak, aq0, aq1, 4);
            ST_MMA(bk, bq0, bq1); ST_LOAD(bk, bq0, bq1, 6);
            ST_MMA(ak, aq0, aq1); ST_MMA(bk, bq0, bq1);
#undef ST_LOAD
#undef ST_MMA
            const int n0 = 16 * qt0 + c, n1 = n0 + 16, mb = 16 * kt + 4 * g;
            float p0[4], p1[4];
#pragma unroll
            for (int jj = 0; jj < 4; ++jj) { const int m = mb + jj; const float wmv = wm[jj];
                const bool k0 = FWD ? (m <= n0) : (m > n0), k1 = FWD ? (m <= n1) : (m > n1);
                p0[jj] = k0 ? s0[jj] * wmv : 0.f; p1[jj] = k1 ? s1[jj] * wmv : 0.f; }
            u32x2 w0 = {cvt_pk_bf16(p0[0], p0[1]), cvt_pk_bf16(p0[2], p0[3])}, w1 = {cvt_pk_bf16(p1[0], p1[1]), cvt_pk_bf16(p1[2], p1[3])};
            *(u32x2*)(lds + P2_OFF + n0 * PRS + mb * 2) = w0; *(u32x2*)(lds + P2_OFF + n1 * PRS + mb * 2) = w1;
        }
        f32x4 o[4];
#pragma unroll
        for (int nt = 0; nt < 4; ++nt) o[nt] = (f32x4){0.f, 0.f, 0.f, 0.f};
        {
            bf16x8 qa[4], qb[4];
#define QS_MMA(D_, S_) do { u32x4 fw = {cvt_pk_bf16(st[2 * (S_)][0], st[2 * (S_)][1]), cvt_pk_bf16(st[2 * (S_)][2], st[2 * (S_)][3]), cvt_pk_bf16(st[2 * (S_) + 1][0], st[2 * (S_) + 1][1]), cvt_pk_bf16(st[2 * (S_) + 1][2], st[2 * (S_) + 1][3])}; \
            const bf16x8 sf = *reinterpret_cast<bf16x8*>(&fw); _Pragma("unroll") for (int nt = 0; nt < 4; ++nt) o[nt] = MFMA16(D_[nt], sf, o[nt]); } while (0)
            qs_load<0>(qa, qs_b); qs_load<1>(qb, qs_b);
            RT_LGKM(8); QS_MMA(qa, 0); qs_load<2>(qa, qs_b);
            RT_LGKM(8); QS_MMA(qb, 1); qs_load<3>(qb, qs_b);
            RT_LGKM(8); QS_MMA(qa, 2); qs_load<4>(qa, qs_b);
            RT_LGKM(8); QS_MMA(qb, 3); qs_load<5>(qb, qs_b);
            RT_LGKM(8); QS_MMA(qa, 4); qs_load<6>(qa, qs_b);
            RT_LGKM(8); QS_MMA(qb, 5); qs_load<7>(qb, qs_b);
            RT_LGKM(8); QS_MMA(qa, 6);
            RT_LGKM(0); QS_MMA(qb, 7);
#undef QS_MMA
        }
        bf16x8 vf0, vf1;
        {
            const s16x4 l0 = tr_rd<0>(vb_tr), h0 = tr_rd<8 * V2RS>(vb_tr), l1 = tr_rd<32 * V2RS>(vb_tr), h1 = tr_rd<40 * V2RS>(vb_tr);
            KT8 ka, kb2;
            kt_load<0>(ka, kb_tr);
            RT_LGKM(8);
            vf0 = cat(l0, h0); vf1 = cat(l1, h1);
            bf16x8 vz0, vz1;
            {
                float f[8];
#pragma unroll
                for (int jj = 0; jj < 8; ++jj) f[jj] = bf2f((bf16_t)vf0[jj]) * zt0[jj];
                u32x4 w = {cvt_pk_bf16(f[0], f[1]), cvt_pk_bf16(f[2], f[3]), cvt_pk_bf16(f[4], f[5]), cvt_pk_bf16(f[6], f[7])};
                vz0 = *reinterpret_cast<bf16x8*>(&w);
#pragma unroll
                for (int jj = 0; jj < 8; ++jj) f[jj] = bf2f((bf16_t)vf1[jj]) * zt1[jj];
                u32x4 w2 = {cvt_pk_bf16(f[0], f[1]), cvt_pk_bf16(f[2], f[3]), cvt_pk_bf16(f[4], f[5]), cvt_pk_bf16(f[6], f[7])};
                vz1 = *reinterpret_cast<bf16x8*>(&w2);
            }
#pragma unroll
            for (int t = 0; t < 16; ++t) st[t] = st[t] * gC;
            kt_load<2>(kb2, kb_tr);  RT_LGKM(8); kt_mma(st[0], st[1], ka, vz0, vz1);
            kt_load<4>(ka, kb_tr);   RT_LGKM(8); kt_mma(st[2], st[3], kb2, vz0, vz1);
            kt_load<6>(kb2, kb_tr);  RT_LGKM(8); kt_mma(st[4], st[5], ka, vz0, vz1);
            kt_load<8>(ka, kb_tr);   RT_LGKM(8); kt_mma(st[6], st[7], kb2, vz0, vz1);
            kt_load<10>(kb2, kb_tr); RT_LGKM(8); kt_mma(st[8], st[9], ka, vz0, vz1);
            kt_load<12>(ka, kb_tr);  RT_LGKM(8); kt_mma(st[10], st[11], kb2, vz0, vz1);
            kt_load<14>(kb2, kb_tr); RT_LGKM(8); kt_mma(st[12], st[13], ka, vz0, vz1);
            RT_LGKM(0); kt_mma(st[14], st[15], kb2, vz0, vz1);
        }
        __syncthreads();
        {
            bf16x8 pa[4], pb[4];
#pragma unroll
            for (int nt = 0; nt < 4; ++nt) { pa[nt] = *(const bf16x8*)(p_rd + nt * 16 * PRS); pb[nt] = *(const bf16x8*)(p_rd + nt * 16 * PRS + 64); }
            RT_CB();
#pragma unroll
            for (int nt = 0; nt < 4; ++nt) { o[nt] = MFMA16(pa[nt], vf0, o[nt]); o[nt] = MFMA16(pb[nt], vf1, o[nt]); }
        }
#pragma unroll
        for (int nt = 0; nt < 4; ++nt)
#pragma unroll
            for (int r = 0; r < 4; ++r) stg_w[(nt * 16 + r) * S2RS] = o[nt][r];
        __syncthreads();
        if (step + 1 < 68) R2_WRITE();
        {
            bf16_t* dst = (fin ? Vg : ((!FWD && step < 4) ? TCB - (size_t)TL * 2048 : Tg));
#pragma unroll
            for (int hf = 0; hf < 2; ++hf) {
                const float* sr = stg_r + hf * 32 * S2RS; const float xi = hf ? xi1 : xi0;
                f32x4 b0 = *(const f32x4*)sr * xi, b1 = *(const f32x4*)(sr + 4) * xi;
                if (fin) { const bf16x8 tvv = hf ? tv1 : tv0; const u32x4 ow = *reinterpret_cast<const u32x4*>(&tvv);
                    b0[0] += bflo(ow[0]); b0[1] += bfhi(ow[0]); b0[2] += bflo(ow[1]); b0[3] += bfhi(ow[1]); b1[0] += bflo(ow[2]); b1[1] += bfhi(ow[2]); b1[2] += bflo(ow[3]); b1[3] += bfhi(ow[3]); }
                const size_t row = (size_t)(rb + srow + 32 * hf);
                store8(dst + row * 2048 + vcol + scp * 8, b0, b1);
                if (fin) {
                    float sm = (b0[0] + b0[1]) + (b0[2] + b0[3]) + (b1[0] + b1[1]) + (b1[2] + b1[3]);
                    float sq = (b0[0] * b0[0] + b0[1] * b0[1]) + (b0[2] * b0[2] + b0[3] * b0[3]) + (b1[0] * b1[0] + b1[1] * b1[1]) + (b1[2] * b1[2] + b1[3] * b1[3]);
#pragma unroll
                    for (int o_ = 1; o_ < 16; o_ <<= 1) { sm += __shfl_xor(sm, o_, 64); sq += __shfl_xor(sq, o_, 64); }
                    if (scp == 0) { float* sp = stats + (row * 4 + h) * 2; unsafeAtomicAdd(sp, sm); unsafeAtomicAdd(sp + 1, sq); }
                }
            }
        }
        __syncthreads();
    }
#undef R2_LOAD
#undef R2_WRITE
    if (FWD) {
        for (int p = tid; p < 4096; p += NTHREADS) { const int r = p >> 4, cp = p & 15; const size_t crow_ = (size_t)b * CTXL + r, row = TL + crow_;
            const u32x4 fa = *(const u32x4*)(Tg + row * 2048 + vcol + cp * 8), fb = *(const u32x4*)(TCB + crow_ * 2048 + vcol + cp * 8);
            f32x4 b0, b1;
            b0[0] = bflo(fa[0]) + bflo(fb[0]); b0[1] = bfhi(fa[0]) + bfhi(fb[0]); b0[2] = bflo(fa[1]) + bflo(fb[1]); b0[3] = bfhi(fa[1]) + bfhi(fb[1]);
            b1[0] = bflo(fa[2]) + bflo(fb[2]); b1[1] = bfhi(fa[2]) + bfhi(fb[2]); b1[2] = bflo(fa[3]) + bflo(fb[3]); b1[3] = bfhi(fa[3]) + bfhi(fb[3]);
            store8(Vg + row * 2048 + vcol + cp * 8, b0, b1);
            float sm = (b0[0] + b0[1]) + (b0[2] + b0[3]) + (b1[0] + b1[1]) + (b1[2] + b1[3]);
            float sq = (b0[0] * b0[0] + b0[1] * b0[1]) + (b0[2] * b0[2] + b0[3] * b0[3]) + (b1[0] * b1[0] + b1[1] * b1[1]) + (b1[2] * b1[2] + b1[3] * b1[3]);
#pragma unroll
            for (int o_ = 1; o_ < 16; o_ <<= 1) { sm += __shfl_xor(sm, o_, 64); sq += __shfl_xor(sq, o_, 64); }
            if (cp == 0) { float* sp = stats + (row * 4 + h) * 2; unsafeAtomicAdd(sp, sm); unsafeAtomicAdd(sp + 1, sq); }
        }
    }
}
}
template <class BarrierFn>
DI void scan_phase(const Args& a, int j, char* lds, const BarrierFn& gbar) {
    const bf16_t* Qg = (const bf16_t*)(a.ws + OFF_R1); const bf16_t* Kg = (const bf16_t*)(a.ws + OFF_R2);
    bf16_t* Vg = (bf16_t*)(a.ws + OFF_R3); bf16_t* OBg = (bf16_t*)(a.ws + OFF_R4); float* stats = (float*)(a.ws + OFF_STATS);
    if (gridDim.x == 256) {
        const int u = blockIdx.x, xcd = u & 7, slot = u >> 3, pair = xcd * 4 + (slot >> 3), idx = slot & 7, b = pair >> 2, h = pair & 3, dir = idx & 1, sl = idx >> 1;
        bf16_t* TCB = (bf16_t*)(a.ws + OFF_TCB);
        if (dir) rt::scan2_dir<1>(Qg, Kg, Vg, OBg, TCB, stats, b, h, sl, a.in[15][j * 4 + h], lds, gbar);
        else     rt::scan2_dir<0>(Qg, Kg, Vg, OBg, TCB, stats, b, h, sl, a.in[16][j * 4 + h], lds, gbar);
        return;
    }
    gbar();
}
DI void zero_stats(const Args& a) {
    float* stz = (float*)(a.ws + OFF_STATS);
    float z = 0.f; asm volatile("" : "+v"(z));
    const f32x4 zv = {z, z, z, z};
    for (int i = blockIdx.x * NTHREADS + opq_tid(); i < TT * 2; i += gridDim.x * NTHREADS) *(f32x4*)(stz + (size_t)i * 4) = zv;
}
__global__ void __launch_bounds__(NTHREADS, 2) fwd_megakernel(Args a) {
    extern __shared__ __attribute__((aligned(16))) unsigned char lds[];
    cg::grid_group grid = cg::this_grid();
    PG8_LAS unsigned char* ldsg = (PG8_LAS unsigned char*)lds;
    const int G = gridDim.x, bx = blockIdx.x;
    bf16_t* wt = (bf16_t*)(a.ws + OFF_WT);
    bf16_t* hbuf = (bf16_t*)(a.ws + OFF_H);
    bf16_t* r1 = (bf16_t*)(a.ws + OFF_R1); bf16_t* r2 = (bf16_t*)(a.ws + OFF_R2); bf16_t* r3 = (bf16_t*)(a.ws + OFF_R3); bf16_t* r4 = (bf16_t*)(a.ws + OFF_R4);

    { volatile LAS unsigned* bst = (volatile LAS unsigned*)((LAS unsigned char*)lds + LDS_MAIN);
      if (threadIdx.x < 4) bst[threadIdx.x] = 0u;
      __syncthreads();
      (void)xcd_barrier_post((unsigned*)(a.ws + OFF_BAR), bst); }
#define GSYNC() do { XcdBarrier xb_; xb_.bar = (unsigned*)(a.ws + OFF_BAR); xb_.x = xb_xcc_id(); xb_.st = (volatile LAS unsigned*)((LAS unsigned char*)lds + LDS_MAIN); xcd_barrier(xb_); } while (0)
    mod_phase(a, (float*)lds);
    __syncthreads();
    rope_phase(a);
    convert_layer_weights(a, 0, (float*)lds);
    if (a.ws == nullptr) grid.sync();
    GSYNC();
    modulate_phase(a);
    GSYNC();

    for (int l = 0; l < 4; ++l) {
        const int j = l >> 1;
        if ((l & 1) == 0) {
            { pg8::Gemm gm{hbuf, wt, TT, ATT_IN, 1024}; pg8::StaticOrder S; S.init(TT, ATT_IN, G, bx);
              EpiAttnIn E{r1, r2, r3, r3 + (size_t)NB * KVS * 256};
              pg8::gemm_phase<EpiAttnIn, pg8::StaticOrder>(ldsg, gm, S, E); }
            GSYNC();
            attn_normrope_phase(a, j);
            GSYNC();
            attn_phase(a, j, (char*)lds);
            GSYNC();
            { pg8::Gemm gm{r4, wt + (size_t)ATT_IN * 1024, TT, 1024, 1024}; pg8::StaticOrder S; S.init(TT, 1024, G, bx);
              EpiPlain E{r1, 1024};
              pg8::gemm_phase<EpiPlain, pg8::StaticOrder>(ldsg, gm, S, E); }
            GSYNC();
        } else {
            const int Mr = (l == 3) ? TL : TT;
            zero_stats(a);
            { pg8::Gemm gm{hbuf, wt, TT, 4096, 1024}; pg8::StaticOrder S; S.init(TT, 4096, G, bx);
              EpiRetIn E{r1, r2, r3, (const h16x2*)(a.ws + OFF_ROPER)};
              pg8::gemm_phase<EpiRetIn, pg8::StaticOrder>(ldsg, gm, S, E); }
            GSYNC();
            scan_phase(a, j, (char*)lds, [&]() { GSYNC(); });
            GSYNC();
            { pg8::Gemm gm{hbuf, wt + (size_t)4096 * 1024, Mr, 2048, 1024}; pg8::StaticOrder S; S.init(Mr, 2048, G, bx);
              EpiGN E{r3, (const float*)(a.ws + OFF_STATS), a.in[14] + (size_t)j * 2048};
              pg8::gemm_phase<EpiGN, pg8::StaticOrder>(ldsg, gm, S, E); }
            GSYNC();
            { pg8::Gemm gm{r3, wt + (size_t)RET_IN * 1024, Mr, 1024, 2048}; pg8::StaticOrder S; S.init(Mr, 1024, G, bx);
              EpiPlain E{r1, 1024};
              pg8::gemm_phase<EpiPlain, pg8::StaticOrder>(ldsg, gm, S, E); }
            GSYNC();
        }
        ln_phase(a, l);
        if (l < 3) { convert_layer_weights(a, l + 1, (float*)lds); GSYNC(); }
    }
}

extern "C" void kernel_launch(void* const* d_in, const int* in_sizes, int n_in, void* d_out, int out_size, void* d_ws, size_t ws_size, hipStream_t stream) {
    static int grid_blocks = 0;
    if (grid_blocks == 0) {
        if (n_in != 17 || out_size != TL * DM || ws_size < WS_END) { fprintf(stderr, "kernel_launch: unexpected shapes n_in %d out %d ws %zu (need %zu)\n", n_in, out_size, ws_size, (size_t)WS_END); grid_blocks = -1; return; }
        int dev = 0, cus = 0, per_cu = 0;
        hipGetDevice(&dev);
        hipDeviceGetAttribute(&cus, hipDeviceAttributeMultiprocessorCount, dev);
        if (hipFuncSetAttribute((const void*)fwd_megakernel, hipFuncAttributeMaxDynamicSharedMemorySize, LDS_BYTES) != hipSuccess) { fprintf(stderr, "kernel_launch: hipFuncSetAttribute failed\n"); grid_blocks = -1; return; }
        if (hipOccupancyMaxActiveBlocksPerMultiprocessor(&per_cu, (const void*)fwd_megakernel, NTHREADS, LDS_BYTES) != hipSuccess || per_cu < 1) { fprintf(stderr, "kernel_launch: occupancy query gave %d\n", per_cu); per_cu = 1; }
        (void)hipGetLastError();
        if (cus < 256) { fprintf(stderr, "kernel_launch: needs 256 CUs (one 512-thread workgroup each), device has %d\n", cus); grid_blocks = -1; return; }
        grid_blocks = 256;
    }
    if (grid_blocks < 0) return;
    if (hipMemsetAsync((char*)d_ws + OFF_BAR, 0, BAR_BYTES, stream) != hipSuccess) { fprintf(stderr, "kernel_launch: memset failed\n"); return; }
    Args a{};
    for (int i = 0; i < 17; ++i) a.in[i] = (const float*)d_in[i];
    a.out = (float*)d_out; a.ws = (unsigned char*)d_ws;
    void* args[] = {&a};
    hipError_t e = hipLaunchCooperativeKernel((const void*)fwd_megakernel, dim3(grid_blocks), dim3(NTHREADS), args, LDS_BYTES, stream);
    if (e != hipSuccess) fprintf(stderr, "kernel_launch: cooperative launch failed: %s (grid %d)\n", hipGetErrorString(e), grid_blocks);
}
```
